# Optimizing an MI355X kernel written in HIP

```python
import math
import jax
import jax.numpy as jnp
from jax import lax
import numpy as np

D_MODEL = 2048
BATCH = 16
SEQ = 256
DEPTH = 2
DEC_BATCH = 2
DEC_SEQ = 1024
PAST_LEN = 256

GRID_W = 64
HEAD_DIM = 128
N_MIX_HEADS = D_MODEL // HEAD_DIM
HGRN_HEADS = N_MIX_HEADS // 4
HGRN_KDIM = 128
HGRN_VDIM = HEAD_DIM
GQA_Q_HEADS = (N_MIX_HEADS - HGRN_HEADS) // 2
GQA_KV_HEADS = GQA_Q_HEADS // 3
DIFF_HEADS = N_MIX_HEADS - HGRN_HEADS - GQA_Q_HEADS
DIFF_QK_DIM = HEAD_DIM // 2
DIFF_V_DIM = HEAD_DIM
HGRN_KW = HGRN_HEADS * HGRN_KDIM
HGRN_WIDTH = HGRN_HEADS * HGRN_VDIM
GQA_WIDTH = GQA_Q_HEADS * HEAD_DIM
DIFF_WIDTH = DIFF_HEADS * DIFF_V_DIM
MIX_WIDTH = HGRN_WIDTH + GQA_WIDTH + DIFF_WIDTH
SPLIT_SIZES = (HGRN_KW, HGRN_WIDTH, HGRN_WIDTH, HGRN_KW, HGRN_KW,
               GQA_Q_HEADS * HEAD_DIM, GQA_KV_HEADS * HEAD_DIM, GQA_KV_HEADS * HEAD_DIM,
               DIFF_HEADS * 2 * DIFF_QK_DIM, DIFF_HEADS * 2 * DIFF_QK_DIM, DIFF_HEADS * DIFF_V_DIM)
SPLIT_POINTS = tuple(sum(SPLIT_SIZES[:i + 1]) for i in range(len(SPLIT_SIZES) - 1))
IN_WIDTH = sum(SPLIT_SIZES)
FFN_DIM = ((8 * D_MODEL // 3 + 255) // 256) * 256
N_MOD = 9
Q_BLOCK = 128
HGRN_CHUNK = 64
ROPE_BASE = 10000.0
EPS = 1e-6

kernel_name = 'hybrid_hgrn2_gqa_diffattn_dit_step'


def rms_norm(x, g):
    xf = x.astype(jnp.float32)
    y = xf * lax.rsqrt(jnp.mean(xf * xf, axis=-1, keepdims=True) + EPS)
    return (y * g.astype(jnp.float32)).astype(x.dtype)


def axial_rope_tables(n_rows, dim):
    quarter = dim // 4
    rows = jnp.repeat(jnp.arange(n_rows), GRID_W)
    cols = jnp.tile(jnp.arange(GRID_W), n_rows)
    pos = jnp.stack([rows, cols], axis=-1).astype(jnp.float32)
    inv = ROPE_BASE ** (-jnp.arange(quarter, dtype=jnp.float32) / quarter)
    ang = pos[:, :, None] * inv
    return jnp.cos(ang), jnp.sin(ang)


def apply_axial_rope(x, cos, sin):
    dim = x.shape[-1]
    q = dim // 4
    xs = x.reshape(x.shape[:-1] + (2, 2, q))
    x1, x2 = xs[..., 0, :], xs[..., 1, :]
    bshape = (1, x.shape[1]) + (1,) * (x.ndim - 3) + (2, q)
    c = cos.reshape(bshape).astype(x.dtype)
    s = sin.reshape(bshape).astype(x.dtype)
    return jnp.stack([x1 * c - x2 * s, x2 * c + x1 * s], axis=-2).reshape(x.shape)


def sweep_query_blocks(block_fn, q):
    B, T = q.shape[0], q.shape[1]
    nb = T // Q_BLOCK
    qb = jnp.moveaxis(q.reshape((B, nb, Q_BLOCK) + q.shape[2:]), 1, 0)
    ob = lax.map(block_fn, qb)
    return jnp.moveaxis(ob, 0, 1).reshape((B, T) + ob.shape[3:])


def gqa_attend(q, k, v):
    B, _, Hq, Dh = q.shape
    Hkv = k.shape[2]
    G = Hq // Hkv
    scale = Dh ** -0.5

    def block(qb):
        qb = qb.reshape(B, Q_BLOCK, Hkv, G, Dh)
        s = jnp.einsum('bqhgd,bkhd->bhgqk', qb, k).astype(jnp.float32) * scale
        p = jax.nn.softmax(s, axis=-1).astype(v.dtype)
        return jnp.einsum('bhgqk,bkhd->bqhgd', p, v).reshape(B, Q_BLOCK, Hq * Dh)

    return sweep_query_blocks(block, q)


def diff_attend(q, k, v, lam, lam_init, sub_g):
    B, _, H, _, d = q.shape
    Dv = v.shape[-1]
    scale = d ** -0.5

    def block(qb):
        s = jnp.einsum('bqhcd,bkhcd->bhcqk', qb, k).astype(jnp.float32) * scale
        p = jax.nn.softmax(s, axis=-1)
        a = (p[:, :, 0] - lam * p[:, :, 1]).astype(v.dtype)
        o = jnp.einsum('bhqk,bkhe->bqhe', a, v)
        o = rms_norm(o, sub_g) * (1.0 - lam_init)
        return o.reshape(B, Q_BLOCK, H * Dv)

    return sweep_query_blocks(block, q)


def hgrn_lower_bounds(raw):
    p = jax.nn.softmax(raw.astype(jnp.float32), axis=0)
    cum = jnp.cumsum(p, axis=0)
    return cum - cum[0:1]


def hgrn_log_forget(z, lb):
    lbf = lb.astype(jnp.float32)
    return jnp.logaddexp(jnp.log(lbf), jnp.log1p(-lbf) + jax.nn.log_sigmoid(z.astype(jnp.float32)))


def hgrn_chunk_scan(q, k, v, logf, S0):
    B, T, H, _ = q.shape
    n = T // HGRN_CHUNK
    tri = jnp.tril(jnp.ones((HGRN_CHUNK, HGRN_CHUNK), dtype=bool))

    def to_chunks(a):
        return jnp.moveaxis(a.reshape(B, n, HGRN_CHUNK, H, a.shape[-1]), 1, 0)

    def step(S, inp):
        qc, kc, vc, lf = inp
        b = jnp.cumsum(lf, axis=1)
        b_last = b[:, -1]
        o_inter = jnp.einsum('bchk,bhkv->bchv', qc * jnp.exp(b), S)
        diff = b[:, :, None] - b[:, None, :]
        decay = jnp.exp(jnp.where(tri[None, :, :, None, None], diff, -jnp.inf))
        A = jnp.einsum('bthk,bshk,btshk->bhts', qc, kc, decay)
        o_intra = jnp.einsum('bhts,bshv->bthv', A, vc)
        S_new = jnp.exp(b_last)[..., None] * S + jnp.einsum(
            'bshk,bshv->bhkv', kc * jnp.exp(b_last[:, None] - b), vc)
        return S_new, o_inter + o_intra

    S_T, o = lax.scan(step, S0, (to_chunks(q), to_chunks(k), to_chunks(v), to_chunks(logf)))
    return jnp.moveaxis(o, 0, 1).reshape(B, T, H, v.shape[-1]), S_T


def hgrn_mixer(hq, hi, hg, hf_f, hf_b, lb, onorm_g, S0):
    B, T, _ = hq.shape
    f32 = jnp.float32
    q = jax.nn.silu(hq).reshape(B, T, HGRN_HEADS, HGRN_KDIM).astype(f32)
    v = hi.reshape(B, T, HGRN_HEADS, HGRN_VDIM).astype(f32)
    logf_f = hgrn_log_forget(hf_f, lb[0]).reshape(B, T, HGRN_HEADS, HGRN_KDIM)
    logf_b = hgrn_log_forget(hf_b, lb[1]).reshape(B, T, HGRN_HEADS, HGRN_KDIM)
    k_f = -jnp.expm1(logf_f)
    k_b = -jnp.expm1(logf_b)
    if S0 is None:
        S0_f = jnp.zeros((B, HGRN_HEADS, HGRN_KDIM, HGRN_VDIM), f32)
        S0_b = S0_f
    else:
        S0_f = S0[:, 0].astype(f32)
        S0_b = S0[:, 1].astype(f32)
    o_f, S_f = hgrn_chunk_scan(q, k_f, v, logf_f, S0_f)
    flip = lambda a: jnp.flip(a, axis=1)
    o_b, S_b = hgrn_chunk_scan(flip(q), flip(k_b), flip(v), flip(logf_b), S0_b)
    o = (o_f + flip(o_b)).astype(hq.dtype)
    o = rms_norm(o, onorm_g) * jax.nn.silu(hg).reshape(B, T, HGRN_HEADS, HGRN_VDIM)
    return o.reshape(B, T, HGRN_WIDTH), jnp.stack([S_f, S_b], axis=1).astype(hq.dtype)


def token_mixers(h, p, layer_idx, ctx, rope):
    B, T, _ = h.shape
    (hq, hi, hg, hff, hfb, gq, gk, gv, dq, dk, dv) = jnp.split(h @ p['w_in'], SPLIT_POINTS, axis=-1)
    o_h, S = hgrn_mixer(hq, hi, hg, hff, hfb, p['lb'], p['hgrn_onorm_g'],
                        None if ctx is None else ctx[4])
    q = rms_norm(gq.reshape(B, T, GQA_Q_HEADS, HEAD_DIM), p['gqa_qnorm_g'])
    k = rms_norm(gk.reshape(B, T, GQA_KV_HEADS, HEAD_DIM), p['gqa_knorm_g'])
    v = gv.reshape(B, T, GQA_KV_HEADS, HEAD_DIM)
    q2 = rms_norm(dq.reshape(B, T, DIFF_HEADS, 2, DIFF_QK_DIM), p['diff_qnorm_g'])
    k2 = rms_norm(dk.reshape(B, T, DIFF_HEADS, 2, DIFF_QK_DIM), p['diff_knorm_g'])
    v2 = dv.reshape(B, T, DIFF_HEADS, DIFF_V_DIM)
    lam_init = 0.8 - 0.6 * math.exp(-0.3 * layer_idx)
    lv = p['diff_lambda'].astype(jnp.float32)
    lam = jnp.exp(jnp.sum(lv[0] * lv[1])) - jnp.exp(jnp.sum(lv[2] * lv[3])) + lam_init
    if ctx is None:
        o_g = gqa_attend(q, k, v)
        o_d = diff_attend(q2, k2, v2, lam, lam_init, p['diff_subln_g'])
        new_ctx = (k, v, k2, v2, S)
    else:
        cos_g, sin_g, cos_d, sin_d = rope
        q = apply_axial_rope(q, cos_g, sin_g)
        k = apply_axial_rope(k, cos_g, sin_g)
        q2 = apply_axial_rope(q2, cos_d, sin_d)
        k2 = apply_axial_rope(k2, cos_d, sin_d)
        kc_g, vc_g, kc_d, vc_d = ctx[0], ctx[1], ctx[2], ctx[3]
        o_g = gqa_attend(q, jnp.concatenate([kc_g.astype(k.dtype), k], axis=1),
                         jnp.concatenate([vc_g.astype(v.dtype), v], axis=1))
        o_d = diff_attend(q2, jnp.concatenate([kc_d.astype(k2.dtype), k2], axis=1),
                          jnp.concatenate([vc_d.astype(v2.dtype), v2], axis=1),
                          lam, lam_init, p['diff_subln_g'])
        new_ctx = None
    out = jnp.concatenate([o_h, o_g, o_d], axis=-1) @ p['w_out']
    return out, new_ctx


def swiglu(h, wg, wu, wd):
    return (jax.nn.silu(h @ wg) * (h @ wu)) @ wd


def layer(x, cond, p, layer_idx, ctx, rope):
    mod = (jax.nn.silu(cond) @ p['w_mod'] + p['b_mod']).reshape(cond.shape[0], 1, N_MOD, D_MODEL)

    def mod_norm(x, j):
        shift, scale = mod[:, :, 3 * j], mod[:, :, 3 * j + 1]
        return rms_norm(x, p['norm_g'][j]) * (1.0 + scale) + shift

    x = x + mod[:, :, 2] * (0.5 * swiglu(mod_norm(x, 0), p['ffn_w_gate'][0], p['ffn_w_up'][0], p['ffn_w_down'][0]))
    m, new_ctx = token_mixers(mod_norm(x, 1), p, layer_idx, ctx, rope)
    x = x + mod[:, :, 5] * m
    x = x + mod[:, :, 8] * (0.5 * swiglu(mod_norm(x, 2), p['ffn_w_gate'][1], p['ffn_w_up'][1], p['ffn_w_down'][1]))
    return x, new_ctx


def setup_inputs(seed: int = 0) -> dict:
    key = jax.random.key(seed)
    ks = iter(jax.random.split(key, 32))
    f32 = jnp.float32
    nrm = lambda shape, s=1.0: jax.random.normal(next(ks), shape, f32) * s
    gain = lambda shape: 1.0 + 0.02 * jax.random.normal(next(ks), shape, f32)
    return {
        'x_prompt': nrm((BATCH, SEQ, D_MODEL)),
        'x_sample': nrm((DEC_BATCH, DEC_SEQ, D_MODEL)),
        'c': nrm((DEC_BATCH, D_MODEL)),
        'cache_gqa_k': nrm((DEC_BATCH, DEPTH, PAST_LEN, GQA_KV_HEADS, HEAD_DIM)),
        'cache_gqa_v': nrm((DEC_BATCH, DEPTH, PAST_LEN, GQA_KV_HEADS, HEAD_DIM)),
        'cache_diff_k': nrm((DEC_BATCH, DEPTH, PAST_LEN, DIFF_HEADS, 2, DIFF_QK_DIM)),
        'cache_diff_v': nrm((DEC_BATCH, DEPTH, PAST_LEN, DIFF_HEADS, DIFF_V_DIM)),
        'state_hgrn': nrm((DEC_BATCH, DEPTH, 2, HGRN_HEADS, HGRN_KDIM, HGRN_VDIM), 0.5),
        'c_ctx': nrm((D_MODEL,)),
        'w_mod': nrm((DEPTH, D_MODEL, N_MOD * D_MODEL), 0.5 * D_MODEL ** -0.5),
        'b_mod': nrm((DEPTH, N_MOD * D_MODEL), 0.02),
        'norm_g': gain((DEPTH, 3, D_MODEL)),
        'ffn_w_gate': nrm((DEPTH, 2, D_MODEL, FFN_DIM), D_MODEL ** -0.5),
        'ffn_w_up': nrm((DEPTH, 2, D_MODEL, FFN_DIM), D_MODEL ** -0.5),
        'ffn_w_down': nrm((DEPTH, 2, FFN_DIM, D_MODEL), FFN_DIM ** -0.5),
        'w_in': nrm((DEPTH, D_MODEL, IN_WIDTH), D_MODEL ** -0.5),
        'w_out': nrm((DEPTH, MIX_WIDTH, D_MODEL), MIX_WIDTH ** -0.5),
        'hgrn_lb_raw': nrm((DEPTH, 2, HGRN_KW), 0.5),
        'hgrn_onorm_g': gain((DEPTH, HGRN_VDIM)),
        'gqa_qnorm_g': gain((DEPTH, HEAD_DIM)),
        'gqa_knorm_g': gain((DEPTH, HEAD_DIM)),
        'diff_qnorm_g': gain((DEPTH, DIFF_QK_DIM)),
        'diff_knorm_g': gain((DEPTH, DIFF_QK_DIM)),
        'diff_lambda': nrm((DEPTH, 4, DIFF_QK_DIM), 0.1),
        'diff_subln_g': gain((DEPTH, DIFF_V_DIM)),
    }


def reference(x_prompt, x_sample, c, cache_gqa_k, cache_gqa_v, cache_diff_k, cache_diff_v,
              state_hgrn, c_ctx, w_mod, b_mod, norm_g, ffn_w_gate, ffn_w_up, ffn_w_down,
              w_in, w_out, hgrn_lb_raw, hgrn_onorm_g, gqa_qnorm_g, gqa_knorm_g,
              diff_qnorm_g, diff_knorm_g, diff_lambda, diff_subln_g):
    lb_all = hgrn_lower_bounds(hgrn_lb_raw)
    grid_rows = x_sample.shape[1] // GRID_W
    rope = axial_rope_tables(grid_rows, HEAD_DIM) + axial_rope_tables(grid_rows, DIFF_QK_DIM)
    cond_ctx = c_ctx[None, :]
    xp, xs = x_prompt, x_sample
    kg_l, vg_l, kd_l, vd_l, s_l = [], [], [], [], []
    for l in range(DEPTH):
        p = {
            'w_mod': w_mod[l], 'b_mod': b_mod[l], 'norm_g': norm_g[l],
            'ffn_w_gate': ffn_w_gate[l], 'ffn_w_up': ffn_w_up[l], 'ffn_w_down': ffn_w_down[l],
            'w_in': w_in[l], 'w_out': w_out[l], 'lb': lb_all[l],
            'hgrn_onorm_g': hgrn_onorm_g[l], 'gqa_qnorm_g': gqa_qnorm_g[l],
            'gqa_knorm_g': gqa_knorm_g[l], 'diff_qnorm_g': diff_qnorm_g[l],
            'diff_knorm_g': diff_knorm_g[l], 'diff_lambda': diff_lambda[l],
            'diff_subln_g': diff_subln_g[l],
        }
        xp, (kg, vg, kd, vd, s) = layer(xp, cond_ctx, p, l, None, None)
        kg_l.append(kg); vg_l.append(vg); kd_l.append(kd); vd_l.append(vd); s_l.append(s)
        ctx = (cache_gqa_k[:, l], cache_gqa_v[:, l], cache_diff_k[:, l], cache_diff_v[:, l], state_hgrn[:, l])
        xs, _ = layer(xs, c, p, l, ctx, rope)
    return (xp, xs, jnp.stack(kg_l, axis=1), jnp.stack(vg_l, axis=1), jnp.stack(kd_l, axis=1),
            jnp.stack(vd_l, axis=1), jnp.stack(s_l, axis=1))
```

```cpp
#include <hip/hip_runtime.h>
#include <hip/hip_bf16.h>
#include <hip/hip_cooperative_groups.h>
#include <cstdio>
namespace cg = cooperative_groups;

#ifndef ONE_LAUNCH
#define ONE_LAUNCH 1
#endif

typedef __hip_bfloat16 bf16;
using bf16x8 = __attribute__((ext_vector_type(8))) short;
using f32x4 = __attribute__((ext_vector_type(4))) float;
#define DEVI __device__ __forceinline__

constexpr int D = 2048, MC = 4096, ML = 2048, M = 6144, FF = 5632, INW = 6144, NMODW = 18432;
constexpr int NT = 512;
constexpr int LDS_BYTES = 147456;
constexpr float EPS = 1e-6f;
constexpr size_t O_GK = 12582912, O_GV = 14680064, O_DK = 16777216, O_DV = 23068672, O_HS = 29360128;

constexpr size_t al(size_t x) { return (x + 255) & ~(size_t)255; }
constexpr size_t WS_CTL = 0;
constexpr size_t WS_BAR = 4096;
constexpr size_t WS_MOD = 4096 + 16384;
constexpr size_t WS_LB = al(WS_MOD + (size_t)2 * 3 * NMODW * 4);
constexpr size_t WS_H = al(WS_LB + 2 * 2 * 512 * 4);
constexpr size_t WS_ACT = al(WS_H + (size_t)M * D * 2);
constexpr size_t WS_PROJ = al(WS_ACT + (size_t)M * FF * 2);
constexpr size_t WS_QG = al(WS_PROJ + (size_t)M * INW * 4);
constexpr size_t WS_KGC = al(WS_QG + (size_t)M * 768 * 2);
constexpr size_t WS_KGL = al(WS_KGC + (size_t)MC * 256 * 2);
constexpr size_t WS_VGC = al(WS_KGL + (size_t)2 * 1280 * 256 * 2);
constexpr size_t WS_VGL = al(WS_VGC + (size_t)16 * 2 * 128 * 256 * 2);
constexpr size_t WS_QD = al(WS_VGL + (size_t)2 * 2 * 128 * 1280 * 2);
constexpr size_t WS_KDC = al(WS_QD + (size_t)M * 768 * 2);
constexpr size_t WS_KDL = al(WS_KDC + (size_t)MC * 768 * 2);
constexpr size_t WS_VDC = al(WS_KDL + (size_t)2 * 1280 * 768 * 2);
constexpr size_t WS_VDL = al(WS_VDC + (size_t)16 * 6 * 128 * 256 * 2);
constexpr size_t WS_MIX = al(WS_VDL + (size_t)2 * 6 * 128 * 1280 * 2);
constexpr size_t WS_OH = al(WS_MIX + (size_t)M * D * 2);
constexpr size_t WS_HU = al(WS_OH + (size_t)2 * M * 512 * 4);
constexpr size_t WS_HD = al(WS_HU + (size_t)768 * 16384 * 4);
constexpr size_t WS_WT = al(WS_HD + (size_t)768 * 128 * 4);
constexpr size_t WL_GU = 0;
constexpr size_t WL_D = WL_GU + (size_t)2 * 11264 * 2048;
constexpr size_t WL_IN = WL_D + (size_t)2 * 2048 * 5632;
constexpr size_t WL_OUT = WL_IN + (size_t)6144 * 2048;
constexpr size_t WL_ELEMS = WL_OUT + (size_t)2048 * 2048;
constexpr size_t WS_END = WS_WT + 2 * WL_ELEMS * 2;

struct P {
  const float *x_prompt, *x_sample, *c, *cgk, *cgv, *cdk, *cdv, *shg, *c_ctx, *w_mod, *b_mod, *norm_g,
      *wg, *wu, *wd, *w_in, *w_out, *lb_raw, *onorm_g, *gqn, *gkn, *dqn, *dkn, *dlam, *dsub;
  float* out;
  unsigned char* ws;
  int ph_lo, ph_hi;
};

typedef __attribute__((address_space(4))) const unsigned char* kaptr_t;
DEVI const void* karg_ptr(int off) {
  return *(const void* const volatile __attribute__((address_space(4)))*)((kaptr_t)__builtin_amdgcn_kernarg_segment_ptr() + off);
}
DEVI int karg_int(int off) {
  return *(const volatile int __attribute__((address_space(4)))*)((kaptr_t)__builtin_amdgcn_kernarg_segment_ptr() + off);
}
DEVI int otid() { int t = threadIdx.x; asm volatile("" : "+v"(t)); return t; }
DEVI int obid() { int b = blockIdx.x; asm volatile("" : "+s"(b)); return b; }
DEVI int ogdim() { int b = gridDim.x; asm volatile("" : "+s"(b)); return b; }
#define LOADP(field) p.field = (decltype(p.field))karg_ptr((int)__builtin_offsetof(P, field))

DEVI unsigned short f2bf(float f) {
  unsigned u = __float_as_uint(f);
  u += 0x7fffu + ((u >> 16) & 1u);
  return (unsigned short)(u >> 16);
}
DEVI unsigned pack2(float a, float b) { return (unsigned)f2bf(a) | ((unsigned)f2bf(b) << 16); }
DEVI float wave_sum(float v) {
#pragma unroll
  for (int o = 32; o >= 1; o >>= 1) v += __shfl_xor(v, o);
  return v;
}
DEVI float silu(float v) { return v / (1.f + __expf(-v)); }

#define XB_TMO      128
#define XB_XCNT(j)  (256  + 64 * (j))
#define XB_XSUB(j)  (1280 + 64 * (j))
#define XB_XGEN(j)  (2304 + 64 * (j))
#define XB_TOP      3328
#define XB_TOPGEN   3392
#define XCD_BAR_WORDS 3456
#define XB_SPIN_CAP (1u << 18)
#define LAS __attribute__((address_space(3)))
constexpr int XB_ST_OFF = LDS_BYTES - 16;
DEVI unsigned xb_ld(unsigned* p) { return __hip_atomic_load(p, __ATOMIC_RELAXED, __HIP_MEMORY_SCOPE_AGENT); }
DEVI unsigned xb_add(unsigned* p, unsigned v) { return __hip_atomic_fetch_add(p, v, __ATOMIC_RELAXED, __HIP_MEMORY_SCOPE_AGENT); }
DEVI unsigned xb_xcc_id() { return (unsigned)__builtin_amdgcn_s_getreg((3 << 11) | 20) & 0xFu; }
#define XB_SPIN(cond, bar) do { unsigned _sp = 0; while (cond) { __builtin_amdgcn_s_sleep(1); \
    if ((++_sp & 255u) == 0u) { if (xb_ld(&(bar)[XB_TMO])) break; if (_sp > XB_SPIN_CAP) { atomicAdd(&(bar)[XB_TMO], 1u); break; } } } } while (0)
DEVI void xcd_barrier_post() {
  P p; LOADP(ws);
  unsigned* bar = (unsigned*)(p.ws + WS_BAR);
  if (otid() == 0) (void)xb_add(&bar[XB_XCNT(xb_xcc_id())], 1u);
}
DEVI void xcd_barrier_complete(unsigned* bar, unsigned x, unsigned& nloc, unsigned& nx) {
  const unsigned G = gridDim.x;
  unsigned sum, cnt, mine, sp = 0u;
  for (;;) {
    sum = 0u; cnt = 0u; mine = 0u;
#pragma unroll
    for (unsigned j = 0; j < 16; ++j) { const unsigned c = xb_ld(&bar[XB_XCNT(j)]); sum += c; cnt += (c > 0u) ? 1u : 0u; mine = (j == x) ? c : mine; }
    if (sum == G) break;
    __builtin_amdgcn_s_sleep(1);
    if ((++sp & 255u) == 0u) { if (xb_ld(&bar[XB_TMO])) break; if (sp > XB_SPIN_CAP) { atomicAdd(&bar[XB_TMO], 1u); break; } }
  }
  nloc = mine > 0u ? mine : 1u; nx = cnt > 0u ? cnt : 1u;
}
DEVI void xcd_barrier() {
  extern __shared__ __attribute__((aligned(16))) unsigned char g_lds[];
  asm volatile("s_waitcnt vmcnt(0)" ::: "memory");
  __syncthreads();
  if (otid() == 0) {
    P p; LOADP(ws);
    unsigned* bar = (unsigned*)(p.ws + WS_BAR);
    volatile LAS unsigned* st = (volatile LAS unsigned*)(g_lds + XB_ST_OFF);
    const unsigned x = xb_xcc_id();
    __builtin_amdgcn_s_waitcnt(0);
    unsigned nloc = st[0], nx = st[1];
    if (nloc == 0u) { xcd_barrier_complete(bar, x, nloc, nx); st[0] = nloc; st[1] = nx; }
    const unsigned old = xb_add(&bar[XB_XSUB(x)], 1u);
    const unsigned gen = old / nloc;
    if (old + 1u == (gen + 1u) * nloc) {
      __builtin_amdgcn_fence(__ATOMIC_RELEASE, "agent");
      asm volatile("s_waitcnt vmcnt(0)" ::: "memory");
      const unsigned og = xb_add(&bar[XB_TOP], 1u);
      const unsigned tg = og / nx;
      if (og + 1u == (tg + 1u) * nx) xb_add(&bar[XB_TOPGEN], 1u);
      else XB_SPIN(xb_ld(&bar[XB_TOPGEN]) == tg, bar);
      __builtin_amdgcn_fence(__ATOMIC_ACQUIRE, "agent");
      xb_add(&bar[XB_XGEN(x)], 1u);
      asm volatile("s_waitcnt vmcnt(0)" ::: "memory");
    } else {
      XB_SPIN(xb_ld(&bar[XB_XGEN(x)]) == gen, bar);
      __builtin_amdgcn_fence(__ATOMIC_ACQUIRE, "agent");
      asm volatile("s_waitcnt vmcnt(0)" ::: "memory");
    }
  }
  __syncthreads();
}

DEVI void conv_load(float (&r)[16], const float* __restrict__ src, int N, int k0, int n0, int tid) {
#pragma unroll
  for (int it = 0; it < 16; ++it) r[it] = __builtin_nontemporal_load(src + (size_t)(k0 + it * 8 + (tid >> 6)) * N + n0 + (tid & 63));
}
DEVI void conv_store(const float (&r)[16], int K, int k0, int n0, bf16* __restrict__ dst, int mode, float* tile, int tid) {
#pragma unroll
  for (int it = 0; it < 16; ++it) tile[(it * 8 + (tid >> 6)) * 65 + (tid & 63)] = r[it];
  __syncthreads();
#pragma unroll
  for (int it = 0; it < 8; ++it) {
    int n = it * 8 + (tid >> 6), kp = (tid & 63) * 2;
    float a = tile[kp * 65 + n], b = tile[(kp + 1) * 65 + n];
    int ng = n0 + n;
    int drow = (mode == 0) ? ng : ((ng >> 4) * 32 + (ng & 15) + (mode == 2 ? 16 : 0));
    __builtin_nontemporal_store(pack2(a, b), (unsigned*)(dst + (size_t)drow * K + k0 + kp));
  }
  __syncthreads();
}

constexpr int SIDE_PER_LAYER = 10784, SIDE_TOTAL = 2 * SIDE_PER_LAYER;
constexpr int SR_MOD = 288, SR_G1 = 3104, SR_G2 = 4512, SR_G3 = 6048, SR_G4 = 6560, SR_G5 = 9376, SR_G6 = 10784;
constexpr int SIDE_CONV_LDS = 49152;
constexpr int SIDE_BATCH = 4;
constexpr bool SIDE_OPP = false;

DEVI void side_item(int u, bool& s_ready) {
  extern __shared__ __attribute__((aligned(16))) unsigned char g_lds[];
  const int tid = otid();
  const int l = u / SIDE_PER_LAYER;
  int t = u % SIDE_PER_LAYER;
  if (t < SR_MOD) {
    P p; LOADP(ws); LOADP(c_ctx); LOADP(c); LOADP(w_mod); LOADP(b_mod);
    float* MOD = (float*)(p.ws + WS_MOD);
    float* s_l = (float*)g_lds;
    float* red = s_l + 3 * 2048;
    if (!s_ready) {
      for (int i = tid; i < 3 * 2048; i += NT) {
        int ci = i >> 11, k = i & 2047;
        float v = ci == 0 ? p.c_ctx[k] : p.c[(ci - 1) * 2048 + k];
        s_l[i] = v / (1.f + expf(-v));
      }
      __syncthreads();
      s_ready = true;
    }
    const int n0 = t * 64, cc = tid & 15, ks = tid >> 4;
    const float* W = p.w_mod + (size_t)l * 2048 * NMODW + n0 + cc * 4;
    float a0[4] = {0, 0, 0, 0}, a1[4] = {0, 0, 0, 0}, a2[4] = {0, 0, 0, 0};
#pragma unroll 8
    for (int kk = 0; kk < 64; ++kk) {
      int k = ks * 64 + kk;
      const float* wp = W + (size_t)k * NMODW;
      float4 w; w.x = __builtin_nontemporal_load(wp); w.y = __builtin_nontemporal_load(wp + 1); w.z = __builtin_nontemporal_load(wp + 2); w.w = __builtin_nontemporal_load(wp + 3);
      float s0 = s_l[k], s1 = s_l[2048 + k], s2 = s_l[4096 + k];
      a0[0] += s0 * w.x; a0[1] += s0 * w.y; a0[2] += s0 * w.z; a0[3] += s0 * w.w;
      a1[0] += s1 * w.x; a1[1] += s1 * w.y; a1[2] += s1 * w.z; a1[3] += s1 * w.w;
      a2[0] += s2 * w.x; a2[1] += s2 * w.y; a2[2] += s2 * w.z; a2[3] += s2 * w.w;
    }
#pragma unroll
    for (int e = 0; e < 4; ++e) { red[tid * 12 + e] = a0[e]; red[tid * 12 + 4 + e] = a1[e]; red[tid * 12 + 8 + e] = a2[e]; }
    __syncthreads();
    if (tid < 192) {
      int ci = tid >> 6, col = tid & 63, c2 = col >> 2, e = col & 3;
      float sacc = 0.f;
      for (int k2 = 0; k2 < 32; ++k2) sacc += red[(k2 * 16 + c2) * 12 + ci * 4 + e];
      MOD[(size_t)(l * 3 + ci) * NMODW + n0 + col] = sacc + p.b_mod[(size_t)l * NMODW + n0 + col];
    }
    __syncthreads();
    return;
  }
  P p; LOADP(ws); LOADP(wg); LOADP(wu); LOADP(wd); LOADP(w_in); LOADP(w_out);
  bf16* WT = (bf16*)(p.ws + WS_WT) + (size_t)l * WL_ELEMS;
  const float* src; bf16* dst; int K, N, mode;
  if (t < SR_G1 || (t >= SR_G4 && t < SR_G5)) {
    const int f = t >= SR_G4;
    t -= f ? SR_G4 : SR_MOD;
    const int up = t / 1408; t = t % 1408;
    src = (up ? p.wu : p.wg) + (size_t)(l * 2 + f) * 2048 * 5632; K = 2048; N = 5632; mode = 1 + up;
    dst = WT + WL_GU + (size_t)f * 11264 * 2048;
  } else if (t < SR_G2 || t >= SR_G5) {
    const int f = t >= SR_G5;
    t -= f ? SR_G5 : SR_G1;
    src = p.wd + (size_t)(l * 2 + f) * 5632 * 2048; K = 5632; N = 2048; mode = 0;
    dst = WT + WL_D + (size_t)f * 2048 * 5632;
  } else if (t < SR_G3) {
    t -= SR_G2; src = p.w_in + (size_t)l * 2048 * 6144; K = 2048; N = 6144; mode = 0; dst = WT + WL_IN;
  } else {
    t -= SR_G3; src = p.w_out + (size_t)l * 2048 * 2048; K = 2048; N = 2048; mode = 0; dst = WT + WL_OUT;
  }
  const int nn = N / 64, k0 = (t / nn) * 128, n0 = (t % nn) * 64;
  float r[SIDE_BATCH][16];
#pragma unroll
  for (int b = 0; b < SIDE_BATCH; ++b) conv_load(r[b], src, N, k0, n0 + b * 64, tid);
#pragma unroll
  for (int b = 0; b < SIDE_BATCH; ++b) conv_store(r[b], K, k0, n0 + b * 64, dst, mode, (float*)(g_lds + SIDE_CONV_LDS), tid);
}

DEVI void side_work(int slot, int required, int lookahead = 0) {
  __shared__ int s_side;
  unsigned *sctr, *done;
  { P p; LOADP(ws); sctr = (unsigned*)(p.ws + WS_CTL) + 8; done = (unsigned*)(p.ws + WS_CTL) + 16 + slot; }
  const unsigned G = ogdim();
  __syncthreads();
  if (otid() == 0) (void)xb_add(done, 1u);
  bool s_ready = false;
  while (true) {
    if (otid() == 0) {
      int v = -1;
      const unsigned c = xb_ld(sctr);
      if (c < (unsigned)SIDE_TOTAL && (c < (unsigned)required || (SIDE_OPP && c < (unsigned)lookahead && xb_ld(done) < G))) v = (int)xb_add(sctr, (unsigned)SIDE_BATCH);
      s_side = (v >= 0 && v < SIDE_TOTAL) ? v : -1;
    }
    __syncthreads();
    const int u = s_side;
    __syncthreads();
    if (u < 0) break;
    if (u % SIDE_PER_LAYER < SR_MOD) {
#pragma unroll 1
      for (int i = 0; i < SIDE_BATCH; ++i) side_item(u + i, s_ready);
    } else side_item(u, s_ready);
  }
}

DEVI void phase0() {
  {
    P p; LOADP(ws); LOADP(lb_raw);
    const int tid = otid();
    float* LB = (float*)(p.ws + WS_LB);
    if (obid() == 0) {
      for (int i = tid; i < 1024; i += NT) {
        int dir = i >> 9, k = i & 511;
        float r0 = p.lb_raw[(0 * 2 + dir) * 512 + k], r1 = p.lb_raw[(1 * 2 + dir) * 512 + k];
        LB[(0 * 2 + dir) * 512 + k] = 0.f;
        LB[(1 * 2 + dir) * 512 + k] = 1.f / (1.f + expf(r0 - r1));
      }
    }
  }
  side_work(0, SR_G2);
}

DEVI void norm_phase(int l, int j, bool first = false) {
  P p; LOADP(ws); LOADP(out); LOADP(norm_g); LOADP(x_prompt); LOADP(x_sample);
  const int tid = otid(), lane = tid & 63, wave = tid >> 6;
  const float* MOD = (const float*)(p.ws + WS_MOD);
  bf16* H = (bf16*)(p.ws + WS_H);
  const float* g = p.norm_g + (size_t)(l * 3 + j) * D;
  for (int row = obid() * 8 + wave; row < M; row += ogdim() * 8) {
    int ci = row < MC ? 0 : 1 + ((row - MC) >> 10);
    const float* mb = MOD + (size_t)(l * 3 + ci) * NMODW;
    const float* sh = mb + (3 * j) * D;
    const float* sc = mb + (3 * j + 1) * D;
    const float* x = !first ? p.out + (size_t)row * D : (row < MC ? p.x_prompt + (size_t)row * D : p.x_sample + (size_t)(row - MC) * D);
    float4 v[8];
    float ss = 0.f;
#pragma unroll
    for (int i = 0; i < 8; ++i) {
      v[i] = *(const float4*)(x + i * 256 + lane * 4);
      ss += v[i].x * v[i].x + v[i].y * v[i].y + v[i].z * v[i].z + v[i].w * v[i].w;
    }
    ss = wave_sum(ss);
    float r = rsqrtf(ss * (1.f / D) + EPS);
#pragma unroll
    for (int i = 0; i < 8; ++i) {
      int col = i * 256 + lane * 4;
      float4 gg = *(const float4*)(g + col), s4 = *(const float4*)(sc + col), h4 = *(const float4*)(sh + col);
      float y0 = v[i].x * r * gg.x * (1.f + s4.x) + h4.x;
      float y1 = v[i].y * r * gg.y * (1.f + s4.y) + h4.y;
      float y2 = v[i].z * r * gg.z * (1.f + s4.z) + h4.z;
      float y3 = v[i].w * r * gg.w * (1.f + s4.w) + h4.w;
      uint2 o; o.x = pack2(y0, y1); o.y = pack2(y2, y3);
      *(uint2*)(H + (size_t)row * D + col) = o;
    }
  }
}

constexpr int BM = 256, BK = 64, HALF = 128, HT = HALF * BK;
DEVI int lds_byte(int r, int c) {
  int st = (r >> 4) * 2 + (c >> 5), rr = r & 15, cc = c & 31, ob = rr * 64 + cc * 2;
  return st * 1024 + (ob ^ (((ob >> 9) & 1) << 5));
}
DEVI void stage_rc(int b, int& R, int& C) {
  int st = b / 1024, sb = b % 1024, swz = sb ^ (((sb >> 9) & 1) << 5);
  R = (st >> 1) * 16 + swz / 64; C = (st & 1) * 32 + (swz % 64) / 2;
}

template <int MODE, int MF, bool FIRST = false, int LEFT = 0>
DEVI void gemm_phase(const bf16* __restrict__ A, const bf16* __restrict__ Bt, int Mr, int N, int K,
                     float* outF, bf16* outB, const float* gate_l  , float coef,
                     const float* xin_c = nullptr, const float* xin_l = nullptr, unsigned* flags = nullptr) {
  extern __shared__ __attribute__((aligned(16))) unsigned char g_lds[];
  bf16* shm = (bf16*)g_lds;
#define SA(b, h) (shm + ((b) * 2 + (h)) * HT)
#define SB(b, h) (shm + (4 + (b) * 2 + (h)) * HT)
#define STAGE(Pp, BASE, br, kt) do { const bf16* _gb = (BASE) + ((long)(br) * K + (long)(kt) * BK); \
    __builtin_amdgcn_global_load_lds((const unsigned*)(_gb + soff0), (unsigned*)((char*)(Pp) + gtid * 16), 16, 0, 0); \
    __builtin_amdgcn_global_load_lds((const unsigned*)(_gb + soff1), (unsigned*)((char*)(Pp) + gtid * 16 + 8192), 16, 0, 0); } while (0)
#define LDA(dst, b, h) for (int m = 0; m < MF; ++m) for (int k = 0; k < 2; ++k) \
    dst[m][k] = *reinterpret_cast<const bf16x8*>((char*)SA(b, h) + lds_byte(wr * (MF * 16) + m * 16 + fr, k * 32 + fq * 8))
#define LDB(dst, b, h) for (int n = 0; n < 2; ++n) for (int k = 0; k < 2; ++k) \
    dst[n][k] = *reinterpret_cast<const bf16x8*>((char*)SB(b, h) + lds_byte(wc * 32 + n * 16 + fr, k * 32 + fq * 8))
#define MMA(ai, bj, At_, Bt_) do { __builtin_amdgcn_s_setprio(1); \
    for (int m = 0; m < MF; ++m) for (int n = 0; n < 2; ++n) for (int k = 0; k < 2; ++k) \
      acc[ai][bj][m][n] = __builtin_amdgcn_mfma_f32_16x16x32_bf16(At_[m][k], Bt_[n][k], acc[ai][bj][m][n], 0, 0, 0); \
    __builtin_amdgcn_s_setprio(0); } while (0)
#define WAIT_V(n) asm volatile("s_waitcnt vmcnt(" #n ")" ::: "memory")
#define WAIT_L(n) asm volatile("s_waitcnt lgkmcnt(" #n ")" ::: "memory")
#define BAR __builtin_amdgcn_s_barrier()
#define SCHED __builtin_amdgcn_sched_barrier(0)
  constexpr int BMA = MF * 64, HALF_A = MF * 32;
  const int nM = Mr / BMA, nN = N / BM, nwg = nM * nN;
  const int gtid = otid(), gbid = obid(), ggd = ogdim();
  const int wid = gtid >> 6, lane = gtid & 63, wr = wid >> 2, wc = wid & 3, fr = lane & 15, fq = lane >> 4;
  const int nt = K / BK;
  unsigned soff0, soff1;
  { int _r, _c; stage_rc(gtid * 16, _r, _c); soff0 = (unsigned)(_r * K + _c); stage_rc(gtid * 16 + 8192, _r, _c); soff1 = (unsigned)(_r * K + _c); }
  const int nNa = (LEFT == 1) ? nN - 4 : nN;
  const int nwga = nM * nNa;
  const int ntiles = (LEFT == 1) ? nwga + 64 : (LEFT == 3 ? 32 : nwg);
  for (int vt = (LEFT == 3 ? ((gbid - 192) % ggd + ggd) % ggd : gbid); vt < ntiles; vt += ggd) {
    int pm, pn;
    if (LEFT == 3) { pm = 16 + (vt & 7); pn = nN - 4 + (vt >> 3); }
    else if (LEFT == 1 && vt >= nwga) { const int v2 = vt - nwga; pm = v2 & 15; pn = nNa + (v2 >> 4); }
    else {
      int wgid = vt;
      { int q = nwga / 8, r = nwga % 8, xcd = wgid % 8, off = wgid / 8;
        wgid = (xcd < r ? xcd * (q + 1) : r * (q + 1) + (xcd - r) * q) + off; }
      int nig = 8 * nNa, gid = wgid / nig, fm = gid * 8, gsz = min(nM - fm, 8);
      pm = fm + ((wgid % nig) % gsz); pn = (wgid % nig) / gsz;
    }
    const int brow = pm * BMA, bcol = pn * BM;
    f32x4 acc[2][2][MF][2];
#pragma unroll
    for (int a = 0; a < 2; ++a) for (int b = 0; b < 2; ++b) for (int m = 0; m < MF; ++m) for (int n = 0; n < 2; ++n) acc[a][b][m][n] = f32x4{0.f, 0.f, 0.f, 0.f};
    bf16x8 At[MF][2], B0[2][2], B1[2][2];
    STAGE(SB(0, 0), Bt, bcol, 0); STAGE(SA(0, 0), A, brow, 0);
    STAGE(SB(0, 1), Bt, bcol + HALF, 0); STAGE(SA(0, 1), A, brow + HALF_A, 0);
    if (wr == 1) BAR;
    WAIT_V(4); BAR;
    STAGE(SB(1, 0), Bt, bcol, 1); STAGE(SA(1, 0), A, brow, 1); STAGE(SB(1, 1), Bt, bcol + HALF, 1);
    WAIT_V(6); BAR;
    for (int t = 0; t < nt - 2; t += 2) {
      if (LEFT == 2 && t == 78 && pm >= 16) {
        if (gtid == 0) {
          unsigned sp = 0;
          while (xb_ld(flags + (pm - 16)) < 4u && ++sp < (1u << 22)) __builtin_amdgcn_s_sleep(2);
          __builtin_amdgcn_fence(__ATOMIC_ACQUIRE, "agent");
          asm volatile("s_waitcnt vmcnt(0)" ::: "memory");
        }
        BAR;
      }
      LDB(B0, 0, 0); SCHED; LDA(At, 0, 0); STAGE(SA(1, 1), A, brow + HALF_A, t + 1);
      WAIT_L(8); BAR; WAIT_L(0); MMA(0, 0, At, B0); BAR; SCHED;
      LDB(B1, 0, 1); STAGE(SB(0, 0), Bt, bcol, t + 2);
      BAR; WAIT_L(0); MMA(0, 1, At, B1); BAR;
      LDA(At, 0, 1); STAGE(SA(0, 0), A, brow, t + 2);
      BAR; WAIT_L(0); MMA(1, 0, At, B0); BAR; SCHED;
      STAGE(SB(0, 1), Bt, bcol + HALF, t + 2);
      WAIT_V(6); BAR; MMA(1, 1, At, B1); BAR;
      LDB(B0, 1, 0); SCHED; LDA(At, 1, 0); STAGE(SA(0, 1), A, brow + HALF_A, t + 2);
      WAIT_L(8); BAR; WAIT_L(0); MMA(0, 0, At, B0); BAR; SCHED;
      LDB(B1, 1, 1); STAGE(SB(1, 0), Bt, bcol, t + 3);
      BAR; WAIT_L(0); MMA(0, 1, At, B1); BAR;
      LDA(At, 1, 1); STAGE(SA(1, 0), A, brow, t + 3);
      BAR; WAIT_L(0); MMA(1, 0, At, B0); BAR; SCHED;
      STAGE(SB(1, 1), Bt, bcol + HALF, t + 3);
      WAIT_V(6); BAR; MMA(1, 1, At, B1); BAR;
    }
    { LDB(B0, 0, 0); LDA(At, 0, 0); STAGE(SA(1, 1), A, brow + HALF_A, nt - 1);
      BAR; WAIT_L(0); MMA(0, 0, At, B0); BAR;
      LDB(B1, 0, 1); BAR; WAIT_L(0); MMA(0, 1, At, B1); BAR;
      LDA(At, 0, 1); WAIT_V(4); BAR; WAIT_L(0); MMA(1, 0, At, B0); MMA(1, 1, At, B1); BAR; }
    { LDB(B0, 1, 0); LDA(At, 1, 0); WAIT_V(2); BAR; WAIT_L(0); MMA(0, 0, At, B0); BAR;
      LDB(B1, 1, 1); WAIT_V(0); BAR; WAIT_L(0); MMA(0, 1, At, B1); BAR;
      LDA(At, 1, 1); BAR; WAIT_L(0); MMA(1, 0, At, B0); MMA(1, 1, At, B1); BAR; }
    if (wr == 0) BAR;
    if (MODE == 0) {
#pragma unroll
      for (int ai = 0; ai < 2; ++ai) for (int bj = 0; bj < 2; ++bj) for (int m = 0; m < MF; ++m) for (int n = 0; n < 2; ++n) for (int j = 0; j < 4; ++j)
        outF[(size_t)(brow + ai * HALF_A + wr * (MF * 16) + m * 16 + fq * 4 + j) * N + (bcol + bj * HALF + wc * 32 + n * 16 + fr)] = acc[ai][bj][m][n][j];
    } else if (MODE == 1) {
      const int ldo = N / 2;
#pragma unroll
      for (int ai = 0; ai < 2; ++ai) for (int bj = 0; bj < 2; ++bj) for (int m = 0; m < MF; ++m) for (int j = 0; j < 4; ++j) {
        float gv = acc[ai][bj][m][0][j], uv = acc[ai][bj][m][1][j];
        float r = gv / (1.f + __expf(-gv)) * uv;
        size_t row = brow + ai * HALF_A + wr * (MF * 16) + m * 16 + fq * 4 + j;
        int col = (bcol + bj * HALF + wc * 32) / 2 + fr;
        reinterpret_cast<unsigned short*>(outB)[row * ldo + col] = f2bf(r);
      }
    } else {
#pragma unroll
      for (int ai = 0; ai < 2; ++ai) for (int m = 0; m < MF; ++m) for (int j = 0; j < 4; ++j) {
        const int row = brow + ai * HALF_A + wr * (MF * 16) + m * 16 + fq * 4 + j;
        const int ci = row < MC ? 0 : 1 + ((row - MC) >> 10);
        const float* gate = gate_l + (size_t)ci * NMODW;
#pragma unroll
        for (int bj = 0; bj < 2; ++bj) for (int n = 0; n < 2; ++n) {
          const int col = bcol + bj * HALF + wc * 32 + n * 16 + fr;
          float* xp = outF + (size_t)row * N + col;
          const float xold = !FIRST ? *xp : (row < MC ? xin_c[(size_t)row * N + col] : xin_l[(size_t)(row - MC) * N + col]);
          *xp = xold + gate[col] * coef * acc[ai][bj][m][n][j];
        }
      }
    }
    WAIT_V(0);
    if (LEFT == 3) {
      BAR;
      if (gtid == 0) {
        __builtin_amdgcn_fence(__ATOMIC_RELEASE, "agent");
        asm volatile("s_waitcnt vmcnt(0)" ::: "memory");
        (void)xb_add(flags + (pm - 16), 1u);
      }
    }
  }
#undef SA
#undef SB
#undef STAGE
#undef LDA
#undef LDB
#undef MMA
}

DEVI void transpose16(const float* __restrict__ src, size_t srow, int col, bf16* __restrict__ dst, float* __restrict__ outp, size_t orow) {
  float v[16];
#pragma unroll
  for (int i = 0; i < 16; ++i) v[i] = src[(size_t)i * srow + col];
  if (outp) {
#pragma unroll
    for (int i = 0; i < 16; ++i) outp[(size_t)i * orow] = v[i];
  }
  uint4 a, b;
  a.x = pack2(v[0], v[1]); a.y = pack2(v[2], v[3]); a.z = pack2(v[4], v[5]); a.w = pack2(v[6], v[7]);
  b.x = pack2(v[8], v[9]); b.y = pack2(v[10], v[11]); b.z = pack2(v[12], v[13]); b.w = pack2(v[14], v[15]);
  *(uint4*)dst = a; *(uint4*)(dst + 8) = b;
}

DEVI void prep_item(int l, int item) {
  P p; LOADP(ws); LOADP(out); LOADP(gqn); LOADP(gkn); LOADP(dqn); LOADP(dkn); LOADP(cgk); LOADP(cgv); LOADP(cdk); LOADP(cdv);
  const int tid = otid(), lane = tid & 63, wave = tid >> 6;
  const float* PROJ = (const float*)(p.ws + WS_PROJ);
  unsigned short* QG = (unsigned short*)(p.ws + WS_QG);
  unsigned short* KGC = (unsigned short*)(p.ws + WS_KGC);
  unsigned short* KGL = (unsigned short*)(p.ws + WS_KGL);
  bf16* VGC = (bf16*)(p.ws + WS_VGC);
  bf16* VGL = (bf16*)(p.ws + WS_VGL);
  unsigned short* QDb = (unsigned short*)(p.ws + WS_QD);
  unsigned short* KDC = (unsigned short*)(p.ws + WS_KDC);
  unsigned short* KDL = (unsigned short*)(p.ws + WS_KDL);
  bf16* VDC = (bf16*)(p.ws + WS_VDC);
  bf16* VDL = (bf16*)(p.ws + WS_VDL);
  {
    if (item < 384) {
      const int r0 = item * 16;
      const bool lat = r0 >= MC;
      const int b = lat ? (r0 - MC) >> 10 : r0 >> 8;
      const int t0 = lat ? (r0 - MC) & 1023 : r0 & 255;
      {
        const int rw = r0 + wave * 2, tw = t0 + wave * 2;
        float xg0[2][8], xg1[2][8], xd[2][24];
#pragma unroll
        for (int i = 0; i < 2; ++i) {
          const float* base = PROJ + (size_t)(rw + i) * INW;
#pragma unroll
          for (int hh = 0; hh < 8; ++hh) { xg0[i][hh] = base[2560 + hh * 128 + lane]; xg1[i][hh] = base[2560 + hh * 128 + 64 + lane]; }
#pragma unroll
          for (int u = 0; u < 24; ++u) xd[i][u] = base[3840 + u * 64 + lane];
        }
        const float gq0 = p.gqn[l * 128 + lane], gq1 = p.gqn[l * 128 + 64 + lane];
        const float gk0 = p.gkn[l * 128 + lane], gk1 = p.gkn[l * 128 + 64 + lane];
        const float gdq = p.dqn[l * 64 + lane], gdk = p.dkn[l * 64 + lane];
        const float invg = exp2f(-(float)(lane & 31) * (13.287712379549449f / 32.f));
        const float invd = exp2f(-(float)(lane & 15) * (13.287712379549449f / 16.f));
#pragma unroll
        for (int i = 0; i < 2; ++i) {
          const int row = rw + i, t = tw + i;
          const float pr = (float)(t >> 6), pc = (float)(t & 63);
          float c0 = 1.f, s0 = 0.f, c1 = 1.f, s1 = 0.f, cd = 1.f, sd = 0.f;
          if (lat) {
            float a0 = pr * invg, a1 = pc * invg, ad = ((lane >> 5) ? pc : pr) * invd;
            c0 = __cosf(a0); s0 = __sinf(a0); c1 = __cosf(a1); s1 = __sinf(a1); cd = __cosf(ad); sd = __sinf(ad);
            if (lane < 32) { s0 = -s0; s1 = -s1; }
            if (!((lane >> 4) & 1)) sd = -sd;
          }
#pragma unroll
          for (int hh = 0; hh < 8; ++hh) {
            float x0 = xg0[i][hh], x1 = xg1[i][hh];
            float ss = wave_sum(x0 * x0 + x1 * x1);
            float r = rsqrtf(ss * (1.f / 128.f) + EPS);
            float y0 = x0 * r * (hh < 6 ? gq0 : gk0), y1 = x1 * r * (hh < 6 ? gq1 : gk1);
            if (!lat && hh >= 6) {
              float* o = p.out + O_GK + ((size_t)(b * 2 + l) * 256 + t) * 256 + (hh - 6) * 128;
              o[lane] = y0; o[64 + lane] = y1;
            }
            if (lat) {
              float p0 = __shfl_xor(y0, 32), p1 = __shfl_xor(y1, 32);
              y0 = y0 * c0 + p0 * s0; y1 = y1 * c1 + p1 * s1;
            }
            unsigned short* dst;
            if (hh < 6) dst = QG + (size_t)row * 768 + hh * 128;
            else if (!lat) dst = KGC + (size_t)row * 256 + (hh - 6) * 128;
            else dst = KGL + ((size_t)b * 1280 + 256 + t) * 256 + (hh - 6) * 128;
            dst[lane] = f2bf(y0); dst[64 + lane] = f2bf(y1);
          }
#pragma unroll
          for (int u = 0; u < 24; ++u) {
            float x = xd[i][u];
            float ss = wave_sum(x * x);
            float r = rsqrtf(ss * (1.f / 64.f) + EPS);
            float y = x * r * (u < 12 ? gdq : gdk);
            if (!lat && u >= 12) p.out[O_DK + ((size_t)(b * 2 + l) * 256 + t) * 768 + (u - 12) * 64 + lane] = y;
            if (lat) { float pp = __shfl_xor(y, 16); y = y * cd + pp * sd; }
            unsigned short* dst;
            if (u < 12) dst = QDb + (size_t)row * 768 + u * 64;
            else if (!lat) dst = KDC + (size_t)row * 768 + (u - 12) * 64;
            else dst = KDL + ((size_t)b * 1280 + 256 + t) * 768 + (u - 12) * 64;
            dst[lane] = f2bf(y);
          }
        }
      }
      for (int it = 0; it < 2; ++it) {
        int col = tid + it * NT;
        const float* src = PROJ + (size_t)r0 * INW;
        if (col < 256) {
          int h = col >> 7, d = col & 127;
          bf16* dst = lat ? VGL + ((size_t)(b * 2 + h) * 128 + d) * 1280 + 256 + t0 : VGC + ((size_t)(b * 2 + h) * 128 + d) * 256 + t0;
          float* o = lat ? nullptr : p.out + O_GV + ((size_t)(b * 2 + l) * 256 + t0) * 256 + col;
          transpose16(src, INW, 3584 + col, dst, o, 256);
        } else {
          int c2 = col - 256, h = c2 >> 7, d = c2 & 127;
          bf16* dst = lat ? VDL + ((size_t)(b * 6 + h) * 128 + d) * 1280 + 256 + t0 : VDC + ((size_t)(b * 6 + h) * 128 + d) * 256 + t0;
          float* o = lat ? nullptr : p.out + O_DV + ((size_t)(b * 2 + l) * 256 + t0) * 768 + c2;
          transpose16(src, INW, 5376 + c2, dst, o, 768);
        }
      }
    } else {
      const int ci = item - 384, b = ci >> 4, s0 = (ci & 15) * 16;
      const float* ck = p.cgk + ((size_t)(b * 2 + l) * 256 + s0) * 256;
      for (int e = tid; e < 16 * 256; e += NT) KGL[((size_t)b * 1280 + s0) * 256 + e] = f2bf(ck[e]);
      const float* dk = p.cdk + ((size_t)(b * 2 + l) * 256 + s0) * 768;
      for (int e = tid; e < 16 * 768; e += NT) KDL[((size_t)b * 1280 + s0) * 768 + e] = f2bf(dk[e]);
      for (int it = 0; it < 2; ++it) {
        int col = tid + it * NT;
        if (col < 256) {
          int h = col >> 7, d = col & 127;
          transpose16(p.cgv + ((size_t)(b * 2 + l) * 256 + s0) * 256, 256, col, VGL + ((size_t)(b * 2 + h) * 128 + d) * 1280 + s0, nullptr, 0);
        } else {
          int c2 = col - 256, h = c2 >> 7, d = c2 & 127;
          transpose16(p.cdv + ((size_t)(b * 2 + l) * 256 + s0) * 768, 768, c2, VDL + ((size_t)(b * 6 + h) * 128 + d) * 1280 + s0, nullptr, 0);
        }
      }
    }
  }
}

constexpr int A_KB = 64 * 136 * 2;
constexpr int A_VB = 128 * 72 * 2;
constexpr int A_K0 = 0, A_V0 = 2 * A_KB;
static_assert(2 * A_KB + 2 * A_VB <= LDS_BYTES, "attn lds");
template <int DQK>
DEVI void attn_wave(const bf16* __restrict__ Qp, int qstride, const bf16* __restrict__ Kp, int kstride,
                    const bf16* __restrict__ Vt, int S, float scale_log2, f32x4 (&o)[8], int tid) {
  extern __shared__ __attribute__((aligned(16))) unsigned char g_lds[];
  const int lane = tid & 63, fr = lane & 15, fq = lane >> 4;
  constexpr int NKS = DQK / 32;
  constexpr int KCH = DQK / 8;
  constexpr int NKL = (64 * KCH) / NT;
  bf16x8 qf[NKS];
#pragma unroll
  for (int ks = 0; ks < NKS; ++ks) qf[ks] = *(const bf16x8*)(Qp + (size_t)fr * qstride + ks * 32 + fq * 8);
#pragma unroll
  for (int t = 0; t < 8; ++t) o[t] = f32x4{0.f, 0.f, 0.f, 0.f};
  float m = -1e30f, lsum = 0.f;
  int kgo[NKL], klo[NKL];
#pragma unroll
  for (int i = 0; i < NKL; ++i) {
    int cidx = tid + i * NT, key = cidx / KCH, c8 = cidx % KCH;
    int lrow = ((key >> 5) * 2 + ((key >> 2) & 1)) * 16 + ((key >> 3) & 3) * 4 + (key & 3);
    kgo[i] = key * kstride + c8 * 8;
    klo[i] = lrow * 272 + c8 * 16;
  }
  int vgo[2], vlo[2];
#pragma unroll
  for (int i = 0; i < 2; ++i) {
    int cidx = tid + i * NT, dv = cidx >> 3, c8 = cidx & 7;
    vgo[i] = dv * S + c8 * 8;
    vlo[i] = dv * 144 + c8 * 16;
  }
  uint4 kr[NKL], vr[2];
#pragma unroll
  for (int i = 0; i < NKL; ++i) kr[i] = *(const uint4*)(Kp + kgo[i]);
#pragma unroll
  for (int i = 0; i < 2; ++i) vr[i] = *(const uint4*)(Vt + vgo[i]);
#pragma unroll
  for (int i = 0; i < NKL; ++i) *(uint4*)(g_lds + A_K0 + klo[i]) = kr[i];
#pragma unroll
  for (int i = 0; i < 2; ++i) *(uint4*)(g_lds + A_V0 + vlo[i]) = vr[i];
  __syncthreads();
  const int nst = S / 64;
  for (int st = 0; st < nst; ++st) {
    const int cur = st & 1;
    if (st + 1 < nst) {
      const bf16* kn = Kp + (size_t)(st + 1) * 64 * kstride;
      const bf16* vn = Vt + (st + 1) * 64;
#pragma unroll
      for (int i = 0; i < NKL; ++i) kr[i] = *(const uint4*)(kn + kgo[i]);
#pragma unroll
      for (int i = 0; i < 2; ++i) vr[i] = *(const uint4*)(vn + vgo[i]);
    }
    const unsigned char* kb = g_lds + A_K0 + cur * A_KB;
    const unsigned char* vb = g_lds + A_V0 + cur * A_VB;
    f32x4 sc[4];
#pragma unroll
    for (int a = 0; a < 4; ++a) {
      f32x4 acc = f32x4{0.f, 0.f, 0.f, 0.f};
#pragma unroll
      for (int ks = 0; ks < NKS; ++ks) {
        bf16x8 kf = *(const bf16x8*)(kb + (a * 16 + fr) * 272 + ks * 64 + fq * 16);
        acc = __builtin_amdgcn_mfma_f32_16x16x32_bf16(kf, qf[ks], acc, 0, 0, 0);
      }
      sc[a] = acc;
    }
    float mx = -1e30f;
#pragma unroll
    for (int a = 0; a < 4; ++a)
#pragma unroll
      for (int j = 0; j < 4; ++j) { sc[a][j] *= scale_log2; mx = fmaxf(mx, sc[a][j]); }
    mx = fmaxf(mx, __shfl_xor(mx, 16));
    mx = fmaxf(mx, __shfl_xor(mx, 32));
    float mn = fmaxf(m, mx);
    float alpha = exp2f(m - mn);
    m = mn;
    float ps = 0.f;
#pragma unroll
    for (int a = 0; a < 4; ++a)
#pragma unroll
      for (int j = 0; j < 4; ++j) { sc[a][j] = exp2f(sc[a][j] - mn); ps += sc[a][j]; }
    lsum = lsum * alpha + ps;
#pragma unroll
    for (int t = 0; t < 8; ++t)
#pragma unroll
      for (int j = 0; j < 4; ++j) o[t][j] *= alpha;
#pragma unroll
    for (int pp = 0; pp < 2; ++pp) {
      union { bf16x8 v; unsigned u[4]; } pb;
      pb.u[0] = pack2(sc[2 * pp][0], sc[2 * pp][1]); pb.u[1] = pack2(sc[2 * pp][2], sc[2 * pp][3]);
      pb.u[2] = pack2(sc[2 * pp + 1][0], sc[2 * pp + 1][1]); pb.u[3] = pack2(sc[2 * pp + 1][2], sc[2 * pp + 1][3]);
#pragma unroll
      for (int t = 0; t < 8; ++t) {
        bf16x8 vf = *(const bf16x8*)(vb + (t * 16 + fr) * 144 + pp * 64 + fq * 16);
        o[t] = __builtin_amdgcn_mfma_f32_16x16x32_bf16(vf, pb.v, o[t], 0, 0, 0);
      }
    }
    if (st + 1 < nst) {
      unsigned char* kw = g_lds + A_K0 + (cur ^ 1) * A_KB;
      unsigned char* vw = g_lds + A_V0 + (cur ^ 1) * A_VB;
#pragma unroll
      for (int i = 0; i < NKL; ++i) *(uint4*)(kw + klo[i]) = kr[i];
#pragma unroll
      for (int i = 0; i < 2; ++i) *(uint4*)(vw + vlo[i]) = vr[i];
    }
    __syncthreads();
  }
  lsum += __shfl_xor(lsum, 16);
  lsum += __shfl_xor(lsum, 32);
  float inv = 1.f / lsum;
#pragma unroll
  for (int t = 0; t < 8; ++t)
#pragma unroll
    for (int j = 0; j < 4; ++j) o[t][j] *= inv;
}

DEVI void attn_dual(const bf16* __restrict__ Qp, int qstride, const bf16* __restrict__ Kp, int kstride,
                    const bf16* __restrict__ Vt, int S, float scale_log2, f32x4 (&o0)[8], f32x4 (&o1)[8], int tid) {
  extern __shared__ __attribute__((aligned(16))) unsigned char g_lds[];
  const int lane = tid & 63, fr = lane & 15, fq = lane >> 4;
  bf16x8 qf[4];
#pragma unroll
  for (int ks = 0; ks < 4; ++ks) qf[ks] = *(const bf16x8*)(Qp + (size_t)fr * qstride + ks * 32 + fq * 8);
#pragma unroll
  for (int t = 0; t < 8; ++t) { o0[t] = f32x4{0.f, 0.f, 0.f, 0.f}; o1[t] = f32x4{0.f, 0.f, 0.f, 0.f}; }
  float m0 = -1e30f, l0 = 0.f, m1 = -1e30f, l1 = 0.f;
  int kgo[2], klo[2];
#pragma unroll
  for (int i = 0; i < 2; ++i) {
    int cidx = tid + i * NT, key = cidx >> 4, c8 = cidx & 15;
    int lrow = ((key >> 5) * 2 + ((key >> 2) & 1)) * 16 + ((key >> 3) & 3) * 4 + (key & 3);
    kgo[i] = key * kstride + c8 * 8;
    klo[i] = lrow * 272 + c8 * 16;
  }
  int vgo[2], vlo[2];
#pragma unroll
  for (int i = 0; i < 2; ++i) {
    int cidx = tid + i * NT, dv = cidx >> 3, c8 = cidx & 7;
    vgo[i] = dv * S + c8 * 8;
    vlo[i] = dv * 144 + c8 * 16;
  }
  uint4 kr0 = *(const uint4*)(Kp + kgo[0]), kr1 = *(const uint4*)(Kp + kgo[1]);
  uint4 vr0 = *(const uint4*)(Vt + vgo[0]), vr1 = *(const uint4*)(Vt + vgo[1]);
  *(uint4*)(g_lds + A_K0 + klo[0]) = kr0; *(uint4*)(g_lds + A_K0 + klo[1]) = kr1;
  *(uint4*)(g_lds + A_V0 + vlo[0]) = vr0; *(uint4*)(g_lds + A_V0 + vlo[1]) = vr1;
  __syncthreads();
  const int nst = S / 64;
  for (int st = 0; st < nst; ++st) {
    const int cur = st & 1;
    if (st + 1 < nst) {
      const bf16* kn = Kp + (size_t)(st + 1) * 64 * kstride;
      const bf16* vn = Vt + (st + 1) * 64;
      kr0 = *(const uint4*)(kn + kgo[0]); kr1 = *(const uint4*)(kn + kgo[1]);
      vr0 = *(const uint4*)(vn + vgo[0]); vr1 = *(const uint4*)(vn + vgo[1]);
    }
    const unsigned char* kb = g_lds + A_K0 + cur * A_KB;
    const unsigned char* vb = g_lds + A_V0 + cur * A_VB;
    f32x4 s0[4], s1[4];
#pragma unroll
    for (int a = 0; a < 4; ++a) {
      f32x4 a0 = f32x4{0.f, 0.f, 0.f, 0.f}, a1 = a0;
#pragma unroll
      for (int ks = 0; ks < 2; ++ks) {
        bf16x8 k0 = *(const bf16x8*)(kb + (a * 16 + fr) * 272 + ks * 64 + fq * 16);
        bf16x8 k1 = *(const bf16x8*)(kb + (a * 16 + fr) * 272 + (ks + 2) * 64 + fq * 16);
        a0 = __builtin_amdgcn_mfma_f32_16x16x32_bf16(k0, qf[ks], a0, 0, 0, 0);
        a1 = __builtin_amdgcn_mfma_f32_16x16x32_bf16(k1, qf[ks + 2], a1, 0, 0, 0);
      }
      s0[a] = a0; s1[a] = a1;
    }
    float x0 = -1e30f, x1 = -1e30f;
#pragma unroll
    for (int a = 0; a < 4; ++a)
#pragma unroll
      for (int j = 0; j < 4; ++j) {
        s0[a][j] *= scale_log2; x0 = fmaxf(x0, s0[a][j]);
        s1[a][j] *= scale_log2; x1 = fmaxf(x1, s1[a][j]);
      }
    x0 = fmaxf(x0, __shfl_xor(x0, 16)); x0 = fmaxf(x0, __shfl_xor(x0, 32));
    x1 = fmaxf(x1, __shfl_xor(x1, 16)); x1 = fmaxf(x1, __shfl_xor(x1, 32));
    const float n0 = fmaxf(m0, x0), n1 = fmaxf(m1, x1);
    const float al0 = exp2f(m0 - n0), al1 = exp2f(m1 - n1);
    m0 = n0; m1 = n1;
    float p0 = 0.f, p1 = 0.f;
#pragma unroll
    for (int a = 0; a < 4; ++a)
#pragma unroll
      for (int j = 0; j < 4; ++j) {
        s0[a][j] = exp2f(s0[a][j] - n0); p0 += s0[a][j];
        s1[a][j] = exp2f(s1[a][j] - n1); p1 += s1[a][j];
      }
    l0 = l0 * al0 + p0; l1 = l1 * al1 + p1;
#pragma unroll
    for (int t = 0; t < 8; ++t)
#pragma unroll
      for (int j = 0; j < 4; ++j) { o0[t][j] *= al0; o1[t][j] *= al1; }
#pragma unroll
    for (int pp = 0; pp < 2; ++pp) {
      typedef unsigned u32x4_t __attribute__((ext_vector_type(4)));
      const u32x4_t w0 = {pack2(s0[2 * pp][0], s0[2 * pp][1]), pack2(s0[2 * pp][2], s0[2 * pp][3]),
                          pack2(s0[2 * pp + 1][0], s0[2 * pp + 1][1]), pack2(s0[2 * pp + 1][2], s0[2 * pp + 1][3])};
      const u32x4_t w1 = {pack2(s1[2 * pp][0], s1[2 * pp][1]), pack2(s1[2 * pp][2], s1[2 * pp][3]),
                          pack2(s1[2 * pp + 1][0], s1[2 * pp + 1][1]), pack2(s1[2 * pp + 1][2], s1[2 * pp + 1][3])};
      struct { bf16x8 v; } b0 = {__builtin_bit_cast(bf16x8, w0)}, b1 = {__builtin_bit_cast(bf16x8, w1)};
#pragma unroll
      for (int t = 0; t < 8; ++t) {
        bf16x8 vf = *(const bf16x8*)(vb + (t * 16 + fr) * 144 + pp * 64 + fq * 16);
        o0[t] = __builtin_amdgcn_mfma_f32_16x16x32_bf16(vf, b0.v, o0[t], 0, 0, 0);
        o1[t] = __builtin_amdgcn_mfma_f32_16x16x32_bf16(vf, b1.v, o1[t], 0, 0, 0);
      }
    }
    if (st + 1 < nst) {
      unsigned char* kw = g_lds + A_K0 + (cur ^ 1) * A_KB;
      unsigned char* vw = g_lds + A_V0 + (cur ^ 1) * A_VB;
      *(uint4*)(kw + klo[0]) = kr0; *(uint4*)(kw + klo[1]) = kr1;
      *(uint4*)(vw + vlo[0]) = vr0; *(uint4*)(vw + vlo[1]) = vr1;
    }
    __syncthreads();
  }
  l0 += __shfl_xor(l0, 16); l0 += __shfl_xor(l0, 32);
  l1 += __shfl_xor(l1, 16); l1 += __shfl_xor(l1, 32);
  const float i0 = 1.f / l0, i1 = 1.f / l1;
#pragma unroll
  for (int t = 0; t < 8; ++t)
#pragma unroll
    for (int j = 0; j < 4; ++j) { o0[t][j] *= i0; o1[t][j] *= i1; }
}

DEVI void attn_item(int l, int ai) {
  P p; LOADP(ws); LOADP(dlam); LOADP(dsub);
  const int tid = otid(), lane = tid & 63, wave = tid >> 6, fr = lane & 15, fq = lane >> 4;
  bf16* MIX = (bf16*)(p.ws + WS_MIX);
  bool lat, diff; int b, h, qb;
  if (ai < 192) { lat = true; diff = ai < 96; int r = ai % 96; b = r / 48; h = (r % 48) / 8; qb = r % 8; }
  else { lat = false; int r = ai - 192; diff = r < 192; r = r % 192; b = r / 12; h = (r % 12) / 2; qb = r % 2; }
  const int S = lat ? 1280 : 256;
  const int rowbase = lat ? MC + b * 1024 : b * 256;
  const int q0 = qb * 128 + wave * 16;
  const size_t row = (size_t)rowbase + q0;
  const float LOG2E = 1.4426950408889634f;
  if (!diff) {
    const bf16* Q = (const bf16*)(p.ws + WS_QG) + row * 768 + h * 128;
    const int hk = h / 3;
    const bf16* K = lat ? (const bf16*)(p.ws + WS_KGL) + (size_t)b * 1280 * 256 + hk * 128
                        : (const bf16*)(p.ws + WS_KGC) + (size_t)b * 256 * 256 + hk * 128;
    const bf16* V = lat ? (const bf16*)(p.ws + WS_VGL) + (size_t)(b * 2 + hk) * 128 * 1280
                        : (const bf16*)(p.ws + WS_VGC) + (size_t)(b * 2 + hk) * 128 * 256;
    f32x4 o[8];
    attn_wave<128>(Q, 768, K, 256, V, S, 0.08838834764831845f * LOG2E, o, tid);
#pragma unroll
    for (int t = 0; t < 8; ++t) {
      uint2 w; w.x = pack2(o[t][0], o[t][1]); w.y = pack2(o[t][2], o[t][3]);
      *(uint2*)(MIX + (row + fr) * D + 512 + h * 128 + t * 16 + fq * 4) = w;
    }
  } else {
    const bf16* Q = (const bf16*)(p.ws + WS_QD) + row * 768 + h * 128;
    const bf16* K = lat ? (const bf16*)(p.ws + WS_KDL) + (size_t)b * 1280 * 768 + h * 128
                        : (const bf16*)(p.ws + WS_KDC) + (size_t)b * 256 * 768 + h * 128;
    const bf16* V = lat ? (const bf16*)(p.ws + WS_VDL) + (size_t)(b * 6 + h) * 128 * 1280
                        : (const bf16*)(p.ws + WS_VDC) + (size_t)(b * 6 + h) * 128 * 256;
    const float* lv = p.dlam + (size_t)l * 256;
    float d1 = wave_sum(lv[lane] * lv[64 + lane]);
    float d2 = wave_sum(lv[128 + lane] * lv[192 + lane]);
    float lam_init = 0.8f - 0.6f * expf(-0.3f * (float)l);
    float lam = expf(d1) - expf(d2) + lam_init;
    f32x4 o0[8], o1[8];
    attn_dual(Q, 768, K, 768, V, S, 0.125f * LOG2E, o0, o1, tid);
    float ss = 0.f;
#pragma unroll
    for (int t = 0; t < 8; ++t)
#pragma unroll
      for (int j = 0; j < 4; ++j) { o0[t][j] -= lam * o1[t][j]; ss += o0[t][j] * o0[t][j]; }
    ss += __shfl_xor(ss, 16);
    ss += __shfl_xor(ss, 32);
    float r = rsqrtf(ss * (1.f / 128.f) + EPS) * (1.f - lam_init);
    const float* sg = p.dsub + l * 128;
#pragma unroll
    for (int t = 0; t < 8; ++t) {
      float4 g4 = *(const float4*)(sg + t * 16 + fq * 4);
      uint2 w; w.x = pack2(o0[t][0] * r * g4.x, o0[t][1] * r * g4.y); w.y = pack2(o0[t][2] * r * g4.z, o0[t][3] * r * g4.w);
      *(uint2*)(MIX + (row + fr) * D + 1280 + h * 128 + t * 16 + fq * 4) = w;
    }
  }
}

constexpr int H_QD = 0;
constexpr int H_KD = H_QD + 64 * 136 * 2;
constexpr int H_KU = H_KD + 64 * 136 * 2;
constexpr int H_VT = H_KU + 128 * 72 * 2;
constexpr int H_ST = H_VT + 128 * 72 * 2;
constexpr int H_P = H_ST + 128 * 136 * 2;
constexpr int H_SEG = H_P + 64 * 72 * 2;
constexpr int H_BM = H_SEG + 4 * 128 * 4;
constexpr int H_END = H_BM + 4 * 128 * 4;
static_assert(H_END <= LDS_BYTES, "hgrn lds");

#define HGRN_FRONT(LOADQV) \
  float bb[16], kk[16]; \
  { const float* zp = PROJ + (size_t)(row0 + seg * 16) * INW + 1536 + dir * 512 + h * 128 + k; \
    const float* qp = PROJ + (size_t)(row0 + seg * 16) * INW + h * 128 + k; \
    const float* vp = qp + 512; \
    _Pragma("unroll") for (int i = 0; i < 16; ++i) { bb[i] = zp[(size_t)i * INW]; if (LOADQV) { qr[i] = qp[(size_t)i * INW]; vr[i] = vp[(size_t)i * INW]; } } \
    _Pragma("unroll") for (int i = 0; i < 16; ++i) { \
      float z = fminf(fmaxf(bb[i], -30.f), 30.f); \
      float ez = __expf(-z); \
      float sg = 1.f / (1.f + ez); \
      bb[i] = __logf(lbv + (1.f - lbv) * sg); \
      kk[i] = (1.f - lbv) * ez * sg; } } \
  if (!dir) { _Pragma("unroll") for (int i = 1; i < 16; ++i) bb[i] += bb[i - 1]; } \
  else { _Pragma("unroll") for (int i = 14; i >= 0; --i) bb[i] += bb[i + 1]; } \
  segtot[seg * 128 + k] = dir ? bb[0] : bb[15]; \
  __syncthreads(); \
  { float off = 0.f; \
    _Pragma("unroll") for (int s2 = 0; s2 < 4; ++s2) { float tv = segtot[s2 * 128 + k]; if (dir ? (s2 > seg) : (s2 < seg)) off += tv; } \
    _Pragma("unroll") for (int i = 0; i < 16; ++i) bb[i] += off; } \
  if (seg == 2) bmid_s[k] = bb[0]; \
  if (!dir && seg == 3) blast_s[k] = bb[15]; \
  if (dir && seg == 0) blast_s[k] = bb[0]; \
  __syncthreads();

#define HGRN_DECODE() \
  const bool lat = id < 256; \
  const int id2 = lat ? id : id - 256; \
  const int cc = lat ? 15 - (id2 >> 4) : 3 - (id2 >> 7); \
  const int scan = lat ? (id2 & 15) : (id2 & 127); \
  const int b = scan >> 3, h = (scan >> 1) & 3, dir = scan & 1; \
  const int nch = lat ? 16 : 4, rowbase = lat ? MC + b * 1024 : b * 256; \
  const int c = dir ? nch - 1 - cc : cc; \
  const int row0 = rowbase + c * 64; \
  const int slot0 = lat ? scan * 16 : 256 + scan * 4; \
  const int k = tid & 127, seg = tid >> 7; \
  const float lbv = ((const float*)(p.ws + WS_LB))[(l * 2 + dir) * 512 + h * 128 + k];

DEVI void hgrn_p1(int l, int id) {
  extern __shared__ __attribute__((aligned(16))) unsigned char g_lds[];
  P p; LOADP(ws);
  const int tid = otid(), lane = tid & 63, wave = tid >> 6, fr = lane & 15, fq = lane >> 4;
  unsigned short* KUs = (unsigned short*)(g_lds + H_KU);
  unsigned short* VTs = (unsigned short*)(g_lds + H_VT);
  float* segtot = (float*)(g_lds + H_SEG);
  float* bmid_s = (float*)(g_lds + H_BM);
  float* blast_s = bmid_s + 128;
  const float* PROJ = (const float*)(p.ws + WS_PROJ);
  HGRN_DECODE();
  float qr[16], vr[16];
  HGRN_FRONT(true);
  {
    const float bl = blast_s[k];
    unsigned ku[8], vv[8];
#pragma unroll
    for (int i = 0; i < 16; i += 2) {
      ku[i >> 1] = pack2(kk[i] * __expf(bl - bb[i]), kk[i + 1] * __expf(bl - bb[i + 1]));
      vv[i >> 1] = pack2(vr[i], vr[i + 1]);
    }
    uint4* kd = (uint4*)(KUs + k * 72 + seg * 16);
    kd[0] = uint4{ku[0], ku[1], ku[2], ku[3]}; kd[1] = uint4{ku[4], ku[5], ku[6], ku[7]};
    uint4* vd = (uint4*)(VTs + k * 72 + seg * 16);
    vd[0] = uint4{vv[0], vv[1], vv[2], vv[3]}; vd[1] = uint4{vv[4], vv[5], vv[6], vv[7]};
    if (seg == 0) ((float*)(p.ws + WS_HD))[(size_t)(slot0 + cc) * 128 + k] = __expf(bl);
  }
  __syncthreads();
  {
    f32x4 U[8];
#pragma unroll
    for (int vt = 0; vt < 8; ++vt) U[vt] = f32x4{0.f, 0.f, 0.f, 0.f};
#pragma unroll
    for (int ks = 0; ks < 2; ++ks) {
      bf16x8 af = *(const bf16x8*)(KUs + (wave * 16 + fr) * 72 + ks * 32 + fq * 8);
#pragma unroll
      for (int vt = 0; vt < 8; ++vt) {
        bf16x8 bf = *(const bf16x8*)(VTs + (vt * 16 + fr) * 72 + ks * 32 + fq * 8);
        U[vt] = __builtin_amdgcn_mfma_f32_16x16x32_bf16(af, bf, U[vt], 0, 0, 0);
      }
    }
    f32x4* hu = (f32x4*)(p.ws + WS_HU) + (size_t)(slot0 + cc) * 4096 + wave * 512 + lane;
#pragma unroll
    for (int vt = 0; vt < 8; ++vt) hu[vt * 64] = U[vt];
  }
  __syncthreads();
}

DEVI void hgrn_p3(int l, int id) {
  extern __shared__ __attribute__((aligned(16))) unsigned char g_lds[];
  P p; LOADP(ws); LOADP(out); LOADP(shg); LOADP(onorm_g);
  const int tid = otid(), lane = tid & 63, wave = tid >> 6, fr = lane & 15, fq = lane >> 4;
  unsigned short* QDs = (unsigned short*)(g_lds + H_QD);
  unsigned short* KDs = (unsigned short*)(g_lds + H_KD);
  unsigned short* QEs = (unsigned short*)(g_lds + H_KU);
  unsigned short* VTs = (unsigned short*)(g_lds + H_VT);
  unsigned short* STs = (unsigned short*)(g_lds + H_ST);
  unsigned short* Ps = (unsigned short*)(g_lds + H_P);
  float* segtot = (float*)(g_lds + H_SEG);
  float* bmid_s = (float*)(g_lds + H_BM);
  float* blast_s = bmid_s + 128;
  const float* PROJ = (const float*)(p.ws + WS_PROJ);
  const bool lat = id < 128;
  const int id2 = lat ? id : id - 128;
  const int nch = lat ? 16 : 4;
  const int c = lat ? (id2 & 15) : (id2 & 3);
  const int bh = lat ? (id2 >> 4) : (id2 >> 2);
  const int b = bh >> 2, h = bh & 3;
  const int row0 = (lat ? MC + b * 1024 : b * 256) + c * 64;
  const int k = tid & 127, seg = tid >> 7;
  const int tt = wave >> 1, vt0 = (wave & 1) * 4;
  f32x4 o[4];
#pragma unroll
  for (int n = 0; n < 4; ++n) o[n] = f32x4{0.f, 0.f, 0.f, 0.f};
  float qr[16], vr[16];
#pragma unroll
  for (int dir = 0; dir < 2; ++dir) {
    const int cc = dir ? nch - 1 - c : c;
    const int scan = bh * 2 + dir;
    const int slot0 = lat ? scan * 16 : 256 + scan * 4;
    const float lbv = ((const float*)(p.ws + WS_LB))[(l * 2 + dir) * 512 + h * 128 + k];
    f32x4 S[8];
    if (lat) {
      const float* st = p.shg + ((((size_t)b * 2 + l) * 2 + dir) * 4 + h) * 16384;
#pragma unroll
      for (int vt = 0; vt < 8; ++vt)
#pragma unroll
        for (int j = 0; j < 4; ++j) S[vt][j] = st[(wave * 16 + fq * 4 + j) * 128 + vt * 16 + fr];
    } else {
#pragma unroll
      for (int vt = 0; vt < 8; ++vt) S[vt] = f32x4{0.f, 0.f, 0.f, 0.f};
    }
#pragma unroll 2
    for (int j2 = 0; j2 < cc; ++j2) {
      const f32x4* hu = (const f32x4*)(p.ws + WS_HU) + (size_t)(slot0 + j2) * 4096 + wave * 512 + lane;
      const f32x4 dd = *(const f32x4*)((const float*)(p.ws + WS_HD) + (size_t)(slot0 + j2) * 128 + wave * 16 + fq * 4);
#pragma unroll
      for (int vt = 0; vt < 8; ++vt) { f32x4 u = hu[vt * 64]; S[vt] = S[vt] * dd + u; }
    }
#pragma unroll
    for (int vt = 0; vt < 8; ++vt) {
      uint2 w; w.x = pack2(S[vt][0], S[vt][1]); w.y = pack2(S[vt][2], S[vt][3]);
      *(uint2*)(STs + (vt * 16 + fr) * 136 + wave * 16 + fq * 4) = w;
    }
    if (!lat && cc == nch - 1) {
      const f32x4* hu = (const f32x4*)(p.ws + WS_HU) + (size_t)(slot0 + cc) * 4096 + wave * 512 + lane;
      const f32x4 dd = *(const f32x4*)((const float*)(p.ws + WS_HD) + (size_t)(slot0 + cc) * 128 + wave * 16 + fq * 4);
      float* so = p.out + O_HS + ((((size_t)b * 2 + l) * 2 + dir) * 4 + h) * 16384;
#pragma unroll
      for (int vt = 0; vt < 8; ++vt) {
        f32x4 u = hu[vt * 64];
        f32x4 sf = S[vt] * dd + u;
#pragma unroll
        for (int j = 0; j < 4; ++j) so[(wave * 16 + fq * 4 + j) * 128 + vt * 16 + fr] = sf[j];
      }
    }
    HGRN_FRONT(dir == 0);
    {
      const float bm = bmid_s[k];
      unsigned vv[8];
#pragma unroll
      for (int i = 0; i < 16; i += 2) {
        int t = seg * 16 + i;
        const float q0 = silu(qr[i]), q1 = silu(qr[i + 1]);
        QDs[t * 136 + k] = f2bf(q0 * __expf(bb[i] - bm));
        QDs[(t + 1) * 136 + k] = f2bf(q1 * __expf(bb[i + 1] - bm));
        QEs[t * 136 + k] = f2bf(q0 * __expf(bb[i]));
        QEs[(t + 1) * 136 + k] = f2bf(q1 * __expf(bb[i + 1]));
        KDs[t * 136 + k] = f2bf(kk[i] * __expf(bm - bb[i]));
        KDs[(t + 1) * 136 + k] = f2bf(kk[i + 1] * __expf(bm - bb[i + 1]));
        vv[i >> 1] = pack2(vr[i], vr[i + 1]);
      }
      if (dir == 0) {
        uint4* vd = (uint4*)(VTs + k * 72 + seg * 16);
        vd[0] = uint4{vv[0], vv[1], vv[2], vv[3]}; vd[1] = uint4{vv[4], vv[5], vv[6], vv[7]};
      }
    }
    __syncthreads();
    {
      const int st0 = (wave & 1) * 2;
      f32x4 a0 = f32x4{0.f, 0.f, 0.f, 0.f}, a1 = a0;
#pragma unroll
      for (int ks = 0; ks < 4; ++ks) {
        bf16x8 af = *(const bf16x8*)(QDs + (tt * 16 + fr) * 136 + ks * 32 + fq * 8);
        bf16x8 b0 = *(const bf16x8*)(KDs + (st0 * 16 + fr) * 136 + ks * 32 + fq * 8);
        bf16x8 b1 = *(const bf16x8*)(KDs + ((st0 + 1) * 16 + fr) * 136 + ks * 32 + fq * 8);
        a0 = __builtin_amdgcn_mfma_f32_16x16x32_bf16(af, b0, a0, 0, 0, 0);
        a1 = __builtin_amdgcn_mfma_f32_16x16x32_bf16(af, b1, a1, 0, 0, 0);
      }
#pragma unroll
      for (int j = 0; j < 4; ++j) {
        int t = tt * 16 + fq * 4 + j, s2 = st0 * 16 + fr;
        bool k0 = dir ? (s2 >= t) : (s2 <= t), k1 = dir ? (s2 + 16 >= t) : (s2 + 16 <= t);
        Ps[t * 72 + s2] = f2bf(k0 ? a0[j] : 0.f);
        Ps[t * 72 + s2 + 16] = f2bf(k1 ? a1[j] : 0.f);
      }
    }
    __syncthreads();
#pragma unroll
    for (int ks = 0; ks < 4; ++ks) {
      bf16x8 af = *(const bf16x8*)(QEs + (tt * 16 + fr) * 136 + ks * 32 + fq * 8);
#pragma unroll
      for (int n = 0; n < 4; ++n) {
        bf16x8 bf = *(const bf16x8*)(STs + ((vt0 + n) * 16 + fr) * 136 + ks * 32 + fq * 8);
        o[n] = __builtin_amdgcn_mfma_f32_16x16x32_bf16(af, bf, o[n], 0, 0, 0);
      }
    }
#pragma unroll
    for (int ks = 0; ks < 2; ++ks) {
      bf16x8 af = *(const bf16x8*)(Ps + (tt * 16 + fr) * 72 + ks * 32 + fq * 8);
#pragma unroll
      for (int n = 0; n < 4; ++n) {
        bf16x8 bf = *(const bf16x8*)(VTs + ((vt0 + n) * 16 + fr) * 72 + ks * 32 + fq * 8);
        o[n] = __builtin_amdgcn_mfma_f32_16x16x32_bf16(af, bf, o[n], 0, 0, 0);
      }
    }
    __syncthreads();
  }
  {
    float hgv[4][4];
    const float* hg = PROJ + (size_t)(row0 + tt * 16 + fq * 4) * INW + 1024 + h * 128 + vt0 * 16 + fr;
#pragma unroll
    for (int j = 0; j < 4; ++j)
#pragma unroll
      for (int n = 0; n < 4; ++n) hgv[j][n] = hg[(size_t)j * INW + n * 16];
    float ss[4];
#pragma unroll
    for (int j = 0; j < 4; ++j) {
      float a = 0.f;
#pragma unroll
      for (int n = 0; n < 4; ++n) a += o[n][j] * o[n][j];
      a += __shfl_xor(a, 1); a += __shfl_xor(a, 2); a += __shfl_xor(a, 4); a += __shfl_xor(a, 8);
      ss[j] = a;
    }
    float* red = segtot;
    if (fr == 0) {
#pragma unroll
      for (int j = 0; j < 4; ++j) red[(tt * 16 + fq * 4 + j) * 2 + (wave & 1)] = ss[j];
    }
    __syncthreads();
    unsigned short* MIX = (unsigned short*)(p.ws + WS_MIX);
    const float* g = p.onorm_g + l * 128 + vt0 * 16 + fr;
#pragma unroll
    for (int j = 0; j < 4; ++j) {
      const int t = tt * 16 + fq * 4 + j;
      const float r = rsqrtf((red[t * 2] + red[t * 2 + 1]) * (1.f / 128.f) + EPS);
#pragma unroll
      for (int n = 0; n < 4; ++n)
        MIX[(size_t)(row0 + t) * D + h * 128 + (vt0 + n) * 16 + fr] = f2bf(o[n][j] * r * g[n * 16] * silu(hgv[j][n]));
    }
  }
  __syncthreads();
}

DEVI void mix_phase(int l, int which) {
  __shared__ int s_item;
  int* ctr;
  { P p; LOADP(ws); ctr = (int*)(p.ws + WS_CTL) + l * 2 + which; }
  const int nitems = which == 0 ? 1184 : 960;
  while (true) {
    if (otid() == 0) s_item = atomicAdd(ctr, 1);
    __syncthreads();
    const int item = s_item;
    __syncthreads();
    if (item >= nitems) break;
    if (which == 0) {
      if (item < 416) prep_item(l, item);
      else hgrn_p1(l, item - 416);
    } else {
      if (item < 128) hgrn_p3(l, item);
      else if (item < 320) attn_item(l, item - 128);
      else if (item < 576) hgrn_p3(l, 128 + item - 320);
      else attn_item(l, 192 + item - 576);
    }
  }
}

DEVI void comb_phase(int l) {
  P p; LOADP(ws); LOADP(onorm_g);
  const int tid = otid(), lane = tid & 63, wave = tid >> 6;
  const float* PROJ = (const float*)(p.ws + WS_PROJ);
  const float* OH = (const float*)(p.ws + WS_OH);
  unsigned short* MIX = (unsigned short*)(p.ws + WS_MIX);
  const float* g = p.onorm_g + l * 128;
  for (int u = obid() * 8 + wave; u < M * 4; u += ogdim() * 8) {
    int row = u >> 2, h = u & 3;
    const float* a = OH + (size_t)row * 512 + h * 128;
    const float* b2 = a + (size_t)M * 512;
    float x0 = a[lane] + b2[lane], x1 = a[64 + lane] + b2[64 + lane];
    float ss = wave_sum(x0 * x0 + x1 * x1);
    float r = rsqrtf(ss * (1.f / 128.f) + EPS);
    const float* hg = PROJ + (size_t)row * INW + 1024 + h * 128;
    MIX[(size_t)row * D + h * 128 + lane] = f2bf(x0 * r * g[lane] * silu(hg[lane]));
    MIX[(size_t)row * D + h * 128 + 64 + lane] = f2bf(x1 * r * g[64 + lane] * silu(hg[64 + lane]));
  }
}

constexpr int NPHASE = 23;
#define RUN(idx, ...) do { if (ph_lo <= (idx) && (idx) < ph_hi) { if ((idx) > ph_lo && (idx) > 1) xcd_barrier(); __VA_ARGS__; } } while (0)
constexpr int GMF = 4;
template <int L>
DEVI void layer_program(cg::grid_group& grid, const int ph_lo, const int ph_hi) {
  constexpr int B0 = 1 + L * 11;
  RUN(B0 + 0, norm_phase(L, 0, L == 0));
  RUN(B0 + 1, { P p; LOADP(ws);
    gemm_phase<1, GMF, false, 1>((const bf16*)(p.ws + WS_H), (const bf16*)(p.ws + WS_WT) + (size_t)L * WL_ELEMS + WL_GU, M, 2 * FF, D, nullptr, (bf16*)(p.ws + WS_ACT), nullptr, 0.f);
    side_work(1 + L * 6 + 0, L * SIDE_PER_LAYER + SR_G2); });
  RUN(B0 + 2, { P p; LOADP(ws); LOADP(out); LOADP(x_prompt); LOADP(x_sample);
    unsigned* lflags = (unsigned*)(p.ws + WS_CTL) + 64 + (L * 2 + 0) * 8;
    gemm_phase<1, GMF, false, 3>((const bf16*)(p.ws + WS_H), (const bf16*)(p.ws + WS_WT) + (size_t)L * WL_ELEMS + WL_GU, M, 2 * FF, D, nullptr, (bf16*)(p.ws + WS_ACT), nullptr, 0.f,
                  nullptr, nullptr, lflags);
    gemm_phase<2, GMF, L == 0, 2>((const bf16*)(p.ws + WS_ACT), (const bf16*)(p.ws + WS_WT) + (size_t)L * WL_ELEMS + WL_D, M, D, FF, p.out, nullptr,
                  (const float*)(p.ws + WS_MOD) + (size_t)L * 3 * NMODW + 2 * D, 0.5f, p.x_prompt, p.x_sample, lflags);
    side_work(1 + L * 6 + 1, L * SIDE_PER_LAYER + SR_G4); });
  RUN(B0 + 3, norm_phase(L, 1));
  RUN(B0 + 4, { P p; LOADP(ws);
    gemm_phase<0, GMF>((const bf16*)(p.ws + WS_H), (const bf16*)(p.ws + WS_WT) + (size_t)L * WL_ELEMS + WL_IN, M, INW, D, (float*)(p.ws + WS_PROJ), nullptr, nullptr, 0.f);
    side_work(1 + L * 6 + 2, L * SIDE_PER_LAYER + SR_G5); });
  RUN(B0 + 5, mix_phase(L, 0));
  RUN(B0 + 6, mix_phase(L, 1));
  RUN(B0 + 7, { P p; LOADP(ws); LOADP(out);
    gemm_phase<2, GMF>((const bf16*)(p.ws + WS_MIX), (const bf16*)(p.ws + WS_WT) + (size_t)L * WL_ELEMS + WL_OUT, M, D, D, p.out, nullptr,
                  (const float*)(p.ws + WS_MOD) + (size_t)L * 3 * NMODW + 5 * D, 1.f);
    side_work(1 + L * 6 + 3, L * SIDE_PER_LAYER + SR_G6); });
  RUN(B0 + 8, norm_phase(L, 2));
  RUN(B0 + 9, { P p; LOADP(ws);
    gemm_phase<1, GMF, false, 1>((const bf16*)(p.ws + WS_H), (const bf16*)(p.ws + WS_WT) + (size_t)L * WL_ELEMS + WL_GU + (size_t)11264 * 2048, M, 2 * FF, D, nullptr, (bf16*)(p.ws + WS_ACT), nullptr, 0.f);
    side_work(1 + L * 6 + 4, L * SIDE_PER_LAYER + SR_G6); });
  RUN(B0 + 10, { P p; LOADP(ws); LOADP(out);
    unsigned* lflags = (unsigned*)(p.ws + WS_CTL) + 64 + (L * 2 + 1) * 8;
    gemm_phase<1, GMF, false, 3>((const bf16*)(p.ws + WS_H), (const bf16*)(p.ws + WS_WT) + (size_t)L * WL_ELEMS + WL_GU + (size_t)11264 * 2048, M, 2 * FF, D, nullptr, (bf16*)(p.ws + WS_ACT), nullptr, 0.f,
                  nullptr, nullptr, lflags);
    gemm_phase<2, GMF, false, 2>((const bf16*)(p.ws + WS_ACT), (const bf16*)(p.ws + WS_WT) + (size_t)L * WL_ELEMS + WL_D + (size_t)2048 * 5632, M, D, FF, p.out, nullptr,
                  (const float*)(p.ws + WS_MOD) + (size_t)L * 3 * NMODW + 8 * D, 0.5f, nullptr, nullptr, lflags);
    side_work(1 + L * 6 + 5, (L == 0 ? SIDE_PER_LAYER + SR_G2 : SIDE_TOTAL)); });
}

__global__ void __launch_bounds__(NT) fwd_kernel(P parg) {
  extern __shared__ __attribute__((aligned(16))) unsigned char g_lds[];
  cg::grid_group grid = cg::this_grid();
  const int ph_lo = karg_int((int)__builtin_offsetof(P, ph_lo)), ph_hi = karg_int((int)__builtin_offsetof(P, ph_hi));
  if (otid() < 4) ((volatile LAS unsigned*)(g_lds + XB_ST_OFF))[otid()] = 0u;
  __syncthreads();
  RUN(0, phase0());
  if (ph_lo == 0 && ph_hi > 1) {
    grid.sync();
    xcd_barrier_post();
  }
  layer_program<0>(grid, ph_lo, ph_hi);
  layer_program<1>(grid, ph_lo, ph_hi);
}

extern "C" void kernel_launch(void* const* d_in, const int* in_sizes, int n_in, void* d_out, int out_size,
                              void* d_ws, size_t ws_size, hipStream_t stream) {
  static int grid_blocks = 0;
  if (!grid_blocks) {
    if (ws_size < WS_END) { fprintf(stderr, "kernel_launch: workspace too small: %zu < %zu\n", ws_size, (size_t)WS_END); grid_blocks = -1; return; }
    int dev = 0, cus = 0, per_cu = 0;
    hipGetDevice(&dev);
    hipDeviceGetAttribute(&cus, hipDeviceAttributeMultiprocessorCount, dev);
    if (hipFuncSetAttribute((const void*)fwd_kernel, hipFuncAttributeMaxDynamicSharedMemorySize, LDS_BYTES) != hipSuccess)
      fprintf(stderr, "kernel_launch: hipFuncSetAttribute failed\n");
    hipOccupancyMaxActiveBlocksPerMultiprocessor(&per_cu, (const void*)fwd_kernel, NT, LDS_BYTES);
    if (per_cu < 1) { fprintf(stderr, "kernel_launch: occupancy query says %d blocks/CU\n", per_cu); per_cu = 1; }
    (void)hipGetLastError();
    grid_blocks = cus * per_cu;
  }
  if (grid_blocks < 0) return;
  (void)hipMemsetAsync(d_ws, 0, WS_MOD, stream);
  P p{};
  const float** pp = (const float**)&p;
  for (int i = 0; i < 25; ++i) pp[i] = (const float*)d_in[i];
  p.out = (float*)d_out; p.ws = (unsigned char*)d_ws;
#if ONE_LAUNCH
  p.ph_lo = 0; p.ph_hi = NPHASE;
  void* args[] = {&p};
  hipError_t e = hipLaunchCooperativeKernel((const void*)fwd_kernel, dim3(grid_blocks), dim3(NT), args, LDS_BYTES, stream);
  if (e != hipSuccess) fprintf(stderr, "cooperative launch failed: %s (grid %d)\n", hipGetErrorString(e), grid_blocks);
#else
  for (int ph = 0; ph < NPHASE; ++ph) {
    p.ph_lo = ph; p.ph_hi = ph + 1;
    hipLaunchKernelGGL(fwd_kernel, dim3(grid_blocks), dim3(NT), LDS_BYTES, stream, p);
  }
#endif
}
```

```cpp
#include <hip/hip_runtime.h>
#include <hip/hip_bf16.h>
#include <hip/hip_cooperative_groups.h>
#include <cstdio>
namespace cg = cooperative_groups;

#ifndef ONE_LAUNCH
#define ONE_LAUNCH 1
#endif

typedef __hip_bfloat16 bf16;
using bf16x8 = __attribute__((ext_vector_type(8))) short;
using f32x4 = __attribute__((ext_vector_type(4))) float;
#define DEVI __device__ __forceinline__

constexpr int D = 2048, MC = 4096, ML = 2048, M = 6144, FF = 5632, INW = 6144, NMODW = 18432;
constexpr int NT = 512;
constexpr int LDS_BYTES = 147456;
constexpr float EPS = 1e-6f;
constexpr size_t O_GK = 12582912, O_GV = 14680064, O_DK = 16777216, O_DV = 23068672, O_HS = 29360128;

constexpr size_t al(size_t x) { return (x + 255) & ~(size_t)255; }
constexpr size_t WS_CTL = 0;
constexpr size_t WS_BAR = 4096;
constexpr size_t WS_MOD = 4096 + 16384;
constexpr size_t WS_LB = al(WS_MOD + (size_t)2 * 3 * NMODW * 4);
constexpr size_t WS_H = al(WS_LB + 2 * 2 * 512 * 4);
constexpr size_t WS_ACT = al(WS_H + (size_t)M * D * 2);
constexpr size_t WS_PROJ = al(WS_ACT + (size_t)M * FF * 2);
constexpr size_t WS_QG = al(WS_PROJ + (size_t)M * INW * 4);
constexpr size_t WS_KGC = al(WS_QG + (size_t)M * 768 * 2);
constexpr size_t WS_KGL = al(WS_KGC + (size_t)MC * 256 * 2);
constexpr size_t WS_VGC = al(WS_KGL + (size_t)2 * 1280 * 256 * 2);
constexpr size_t WS_VGL = al(WS_VGC + (size_t)16 * 2 * 128 * 256 * 2);
constexpr size_t WS_QD = al(WS_VGL + (size_t)2 * 2 * 128 * 1280 * 2);
constexpr size_t WS_KDC = al(WS_QD + (size_t)M * 768 * 2);
constexpr size_t WS_KDL = al(WS_KDC + (size_t)MC * 768 * 2);
constexpr size_t WS_VDC = al(WS_KDL + (size_t)2 * 1280 * 768 * 2);
constexpr size_t WS_VDL = al(WS_VDC + (size_t)16 * 6 * 128 * 256 * 2);
constexpr size_t WS_MIX = al(WS_VDL + (size_t)2 * 6 * 128 * 1280 * 2);
constexpr size_t WS_OH = al(WS_MIX + (size_t)M * D * 2);
constexpr size_t WS_HU = al(WS_OH + (size_t)2 * M * 512 * 4);
constexpr size_t WS_HD = al(WS_HU + (size_t)768 * 16384 * 4);
constexpr size_t WS_WT = al(WS_HD + (size_t)768 * 128 * 4);
constexpr size_t WL_GU = 0;
constexpr size_t WL_D = WL_GU + (size_t)2 * 11264 * 2048;
constexpr size_t WL_IN = WL_D + (size_t)2 * 2048 * 5632;
constexpr size_t WL_OUT = WL_IN + (size_t)6144 * 2048;
constexpr size_t WL_ELEMS = WL_OUT + (size_t)2048 * 2048;
constexpr size_t WS_END = WS_WT + 2 * WL_ELEMS * 2;

struct P {
  const float *x_prompt, *x_sample, *c, *cgk, *cgv, *cdk, *cdv, *shg, *c_ctx, *w_mod, *b_mod, *norm_g,
      *wg, *wu, *wd, *w_in, *w_out, *lb_raw, *onorm_g, *gqn, *gkn, *dqn, *dkn, *dlam, *dsub;
  float* out;
  unsigned char* ws;
  int ph_lo, ph_hi;
};

typedef __attribute__((address_space(4))) const unsigned char* kaptr_t;
DEVI const void* karg_ptr(int off) {
  return *(const void* const volatile __attribute__((address_space(4)))*)((kaptr_t)__builtin_amdgcn_kernarg_segment_ptr() + off);
}
DEVI int karg_int(int off) {
  return *(const volatile int __attribute__((address_space(4)))*)((kaptr_t)__builtin_amdgcn_kernarg_segment_ptr() + off);
}
DEVI int otid() { int t = threadIdx.x; asm volatile("" : "+v"(t)); return t; }
DEVI int obid() { int b = blockIdx.x; asm volatile("" : "+s"(b)); return b; }
DEVI int ogdim() { int b = gridDim.x; asm volatile("" : "+s"(b)); return b; }
#define LOADP(field) p.field = (decltype(p.field))karg_ptr((int)__builtin_offsetof(P, field))

DEVI unsigned short f2bf(float f) {
  unsigned u = __float_as_uint(f);
  u += 0x7fffu + ((u >> 16) & 1u);
  return (unsigned short)(u >> 16);
}
DEVI unsigned pack2(float a, float b) { return (unsigned)f2bf(a) | ((unsigned)f2bf(b) << 16); }
DEVI float wave_sum(float v) {
#pragma unroll
  for (int o = 32; o >= 1; o >>= 1) v += __shfl_xor(v, o);
  return v;
}
DEVI float silu(float v) { return v / (1.f + __expf(-v)); }

#define XB_TMO      128
#define XB_XCNT(j)  (256  + 64 * (j))
#define XB_XSUB(j)  (1280 + 64 * (j))
#define XB_XGEN(j)  (2304 + 64 * (j))
#define XB_TOP      3328
#define XB_TOPGEN   3392
#define XCD_BAR_WORDS 3456
#define XB_SPIN_CAP (1u << 18)
#define LAS __attribute__((address_space(3)))
constexpr int XB_ST_OFF = LDS_BYTES - 16;
DEVI unsigned xb_ld(unsigned* p) { return __hip_atomic_load(p, __ATOMIC_RELAXED, __HIP_MEMORY_SCOPE_AGENT); }
DEVI unsigned xb_add(unsigned* p, unsigned v) { return __hip_atomic_fetch_add(p, v, __ATOMIC_RELAXED, __HIP_MEMORY_SCOPE_AGENT); }
DEVI unsigned xb_xcc_id() { return (unsigned)__builtin_amdgcn_s_getreg((3 << 11) | 20) & 0xFu; }
#define XB_SPIN(cond, bar) do { unsigned _sp = 0; while (cond) { __builtin_amdgcn_s_sleep(1); \
    if ((++_sp & 255u) == 0u) { if (xb_ld(&(bar)[XB_TMO])) break; if (_sp > XB_SPIN_CAP) { atomicAdd(&(bar)[XB_TMO], 1u); break; } } } } while (0)
DEVI void xcd_barrier_post() {
  P p; LOADP(ws);
  unsigned* bar = (unsigned*)(p.ws + WS_BAR);
  if (otid() == 0) (void)xb_add(&bar[XB_XCNT(xb_xcc_id())], 1u);
}
DEVI void xcd_barrier_complete(unsigned* bar, unsigned x, unsigned& nloc, unsigned& nx) {
  const unsigned G = gridDim.x;
  unsigned sum, cnt, mine, sp = 0u;
  for (;;) {
    sum = 0u; cnt = 0u; mine = 0u;
#pragma unroll
    for (unsigned j = 0; j < 16; ++j) { const unsigned c = xb_ld(&bar[XB_XCNT(j)]); sum += c; cnt += (c > 0u) ? 1u : 0u; mine = (j == x) ? c : mine; }
    if (sum == G) break;
    __builtin_amdgcn_s_sleep(1);
    if ((++sp & 255u) == 0u) { if (xb_ld(&bar[XB_TMO])) break; if (sp > XB_SPIN_CAP) { atomicAdd(&bar[XB_TMO], 1u); break; } }
  }
  nloc = mine > 0u ? mine : 1u; nx = cnt > 0u ? cnt : 1u;
}
DEVI void xcd_barrier() {
  extern __shared__ __attribute__((aligned(16))) unsigned char g_lds[];
  asm volatile("s_waitcnt vmcnt(0)" ::: "memory");
  __syncthreads();
  if (otid() == 0) {
    P p; LOADP(ws);
    unsigned* bar = (unsigned*)(p.ws + WS_BAR);
    volatile LAS unsigned* st = (volatile LAS unsigned*)(g_lds + XB_ST_OFF);
    const unsigned x = xb_xcc_id();
    __builtin_amdgcn_s_waitcnt(0);
    unsigned nloc = st[0], nx = st[1];
    if (nloc == 0u) { xcd_barrier_complete(bar, x, nloc, nx); st[0] = nloc; st[1] = nx; }
    const unsigned old = xb_add(&bar[XB_XSUB(x)], 1u);
    const unsigned gen = old / nloc;
    if (old + 1u == (gen + 1u) * nloc) {
      __builtin_amdgcn_fence(__ATOMIC_RELEASE, "agent");
      asm volatile("s_waitcnt vmcnt(0)" ::: "memory");
      const unsigned og = xb_add(&bar[XB_TOP], 1u);
      const unsigned tg = og / nx;
      if (og + 1u == (tg + 1u) * nx) xb_add(&bar[XB_TOPGEN], 1u);
      else XB_SPIN(xb_ld(&bar[XB_TOPGEN]) == tg, bar);
      __builtin_amdgcn_fence(__ATOMIC_ACQUIRE, "agent");
      xb_add(&bar[XB_XGEN(x)], 1u);
      asm volatile("s_waitcnt vmcnt(0)" ::: "memory");
    } else {
      XB_SPIN(xb_ld(&bar[XB_XGEN(x)]) == gen, bar);
      __builtin_amdgcn_fence(__ATOMIC_ACQUIRE, "agent");
      asm volatile("s_waitcnt vmcnt(0)" ::: "memory");
    }
  }
  __syncthreads();
}

DEVI void conv_load(float (&r)[16], const float* __restrict__ src, int N, int k0, int n0, int tid) {
#pragma unroll
  for (int it = 0; it < 16; ++it) r[it] = __builtin_nontemporal_load(src + (size_t)(k0 + it * 8 + (tid >> 6)) * N + n0 + (tid & 63));
}
DEVI void conv_store(const float (&r)[16], int K, int k0, int n0, bf16* __restrict__ dst, int mode, float* tile, int tid) {
#pragma unroll
  for (int it = 0; it < 16; ++it) tile[(it * 8 + (tid >> 6)) * 65 + (tid & 63)] = r[it];
  __syncthreads();
#pragma unroll
  for (int it = 0; it < 8; ++it) {
    int n = it * 8 + (tid >> 6), kp = (tid & 63) * 2;
    float a = tile[kp * 65 + n], b = tile[(kp + 1) * 65 + n];
    int ng = n0 + n;
    int drow = (mode == 0) ? ng : ((ng >> 4) * 32 + (ng & 15) + (mode == 2 ? 16 : 0));
    __builtin_nontemporal_store(pack2(a, b), (unsigned*)(dst + (size_t)drow * K + k0 + kp));
  }
  __syncthreads();
}

constexpr int SIDE_PER_LAYER = 10784, SIDE_TOTAL = 2 * SIDE_PER_LAYER;
constexpr int SR_MOD = 288, SR_G1 = 3104, SR_G2 = 4512, SR_G3 = 6048, SR_G4 = 6560, SR_G5 = 9376, SR_G6 = 10784;
constexpr int SIDE_CONV_LDS = 49152;
constexpr int SIDE_BATCH = 4;
constexpr bool SIDE_OPP = false;

DEVI void side_item(int u, bool& s_ready) {
  extern __shared__ __attribute__((aligned(16))) unsigned char g_lds[];
  const int tid = otid();
  const int l = u / SIDE_PER_LAYER;
  int t = u % SIDE_PER_LAYER;
  if (t < SR_MOD) {
    P p; LOADP(ws); LOADP(c_ctx); LOADP(c); LOADP(w_mod); LOADP(b_mod);
    float* MOD = (float*)(p.ws + WS_MOD);
    float* s_l = (float*)g_lds;
    float* red = s_l + 3 * 2048;
    if (!s_ready) {
      for (int i = tid; i < 3 * 2048; i += NT) {
        int ci = i >> 11, k = i & 2047;
        float v = ci == 0 ? p.c_ctx[k] : p.c[(ci - 1) * 2048 + k];
        s_l[i] = v / (1.f + expf(-v));
      }
      __syncthreads();
      s_ready = true;
    }
    const int n0 = t * 64, cc = tid & 15, ks = tid >> 4;
    const float* W = p.w_mod + (size_t)l * 2048 * NMODW + n0 + cc * 4;
    float a0[4] = {0, 0, 0, 0}, a1[4] = {0, 0, 0, 0}, a2[4] = {0, 0, 0, 0};
#pragma unroll 8
    for (int kk = 0; kk < 64; ++kk) {
      int k = ks * 64 + kk;
      const float* wp = W + (size_t)k * NMODW;
      float4 w; w.x = __builtin_nontemporal_load(wp); w.y = __builtin_nontemporal_load(wp + 1); w.z = __builtin_nontemporal_load(wp + 2); w.w = __builtin_nontemporal_load(wp + 3);
      float s0 = s_l[k], s1 = s_l[2048 + k], s2 = s_l[4096 + k];
      a0[0] += s0 * w.x; a0[1] += s0 * w.y; a0[2] += s0 * w.z; a0[3] += s0 * w.w;
      a1[0] += s1 * w.x; a1[1] += s1 * w.y; a1[2] += s1 * w.z; a1[3] += s1 * w.w;
      a2[0] += s2 * w.x; a2[1] += s2 * w.y; a2[2] += s2 * w.z; a2[3] += s2 * w.w;
    }
#pragma unroll
    for (int e = 0; e < 4; ++e) { red[tid * 12 + e] = a0[e]; red[tid * 12 + 4 + e] = a1[e]; red[tid * 12 + 8 + e] = a2[e]; }
    __syncthreads();
    if (tid < 192) {
      int ci = tid >> 6, col = tid & 63, c2 = col >> 2, e = col & 3;
      float sacc = 0.f;
      for (int k2 = 0; k2 < 32; ++k2) sacc += red[(k2 * 16 + c2) * 12 + ci * 4 + e];
      MOD[(size_t)(l * 3 + ci) * NMODW + n0 + col] = sacc + p.b_mod[(size_t)l * NMODW + n0 + col];
    }
    __syncthreads();
    return;
  }
  P p; LOADP(ws); LOADP(wg); LOADP(wu); LOADP(wd); LOADP(w_in); LOADP(w_out);
  bf16* WT = (bf16*)(p.ws + WS_WT) + (size_t)l * WL_ELEMS;
  const float* src; bf16* dst; int K, N, mode;
  if (t < SR_G1 || (t >= SR_G4 && t < SR_G5)) {
    const int f = t >= SR_G4;
    t -= f ? SR_G4 : SR_MOD;
    const int up = t / 1408; t = t % 1408;
    src = (up ? p.wu : p.wg) + (size_t)(l * 2 + f) * 2048 * 5632; K = 2048; N = 5632; mode = 1 + up;
    dst = WT + WL_GU + (size_t)f * 11264 * 2048;
  } else if (t < SR_G2 || t >= SR_G5) {
    const int f = t >= SR_G5;
    t -= f ? SR_G5 : SR_G1;
    src = p.wd + (size_t)(l * 2 + f) * 5632 * 2048; K = 5632; N = 2048; mode = 0;
    dst = WT + WL_D + (size_t)f * 2048 * 5632;
  } else if (t < SR_G3) {
    t -= SR_G2; src = p.w_in + (size_t)l * 2048 * 6144; K = 2048; N = 6144; mode = 0; dst = WT + WL_IN;
  } else {
    t -= SR_G3; src = p.w_out + (size_t)l * 2048 * 2048; K = 2048; N = 2048; mode = 0; dst = WT + WL_OUT;
  }
  const int nn = N / 64, k0 = (t / nn) * 128, n0 = (t % nn) * 64;
  float r[SIDE_BATCH][16];
#pragma unroll
  for (int b = 0; b < SIDE_BATCH; ++b) conv_load(r[b], src, N, k0, n0 + b * 64, tid);
#pragma unroll
  for (int b = 0; b < SIDE_BATCH; ++b) conv_store(r[b], K, k0, n0 + b * 64, dst, mode, (float*)(g_lds + SIDE_CONV_LDS), tid);
}

DEVI void side_work(int slot, int required, int lookahead = 0) {
  __shared__ int s_side;
  unsigned *sctr, *done;
  { P p; LOADP(ws); sctr = (unsigned*)(p.ws + WS_CTL) + 8; done = (unsigned*)(p.ws + WS_CTL) + 16 + slot; }
  const unsigned G = ogdim();
  __syncthreads();
  if (otid() == 0) (void)xb_add(done, 1u);
  bool s_ready = false;
  while (true) {
    if (otid() == 0) {
      int v = -1;
      const unsigned c = xb_ld(sctr);
      if (c < (unsigned)SIDE_TOTAL && (c < (unsigned)required || (SIDE_OPP && c < (unsigned)lookahead && xb_ld(done) < G))) v = (int)xb_add(sctr, (unsigned)SIDE_BATCH);
      s_side = (v >= 0 && v < SIDE_TOTAL) ? v : -1;
    }
    __syncthreads();
    const int u = s_side;
    __syncthreads();
    if (u < 0) break;
    if (u % SIDE_PER_LAYER < SR_MOD) {
#pragma unroll 1
      for (int i = 0; i < SIDE_BATCH; ++i) side_item(u + i, s_ready);
    } else side_item(u, s_ready);
  }
}

DEVI void phase0() {
  {
    P p; LOADP(ws); LOADP(lb_raw);
    const int tid = otid();
    float* LB = (float*)(p.ws + WS_LB);
    if (obid() == 0) {
      for (int i = tid; i < 1024; i += NT) {
        int dir = i >> 9, k = i & 511;
        float r0 = p.lb_raw[(0 * 2 + dir) * 512 + k], r1 = p.lb_raw[(1 * 2 + dir) * 512 + k];
        LB[(0 * 2 + dir) * 512 + k] = 0.f;
        LB[(1 * 2 + dir) * 512 + k] = 1.f / (1.f + expf(r0 - r1));
      }
    }
  }
  side_work(0, SR_G2);
}

DEVI void norm_phase(int l, int j, bool first = false) {
  P p; LOADP(ws); LOADP(out); LOADP(norm_g); LOADP(x_prompt); LOADP(x_sample);
  const int tid = otid(), lane = tid & 63, wave = tid >> 6;
  const float* MOD = (const float*)(p.ws + WS_MOD);
  bf16* H = (bf16*)(p.ws + WS_H);
  const float* g = p.norm_g + (size_t)(l * 3 + j) * D;
  for (int row = obid() * 8 + wave; row < M; row += ogdim() * 8) {
    int ci = row < MC ? 0 : 1 + ((row - MC) >> 10);
    const float* mb = MOD + (size_t)(l * 3 + ci) * NMODW;
    const float* sh = mb + (3 * j) * D;
    const float* sc = mb + (3 * j + 1) * D;
    const float* x = !first ? p.out + (size_t)row * D : (row < MC ? p.x_prompt + (size_t)row * D : p.x_sample + (size_t)(row - MC) * D);
    float4 v[8];
    float ss = 0.f;
#pragma unroll
    for (int i = 0; i < 8; ++i) {
      v[i] = *(const float4*)(x + i * 256 + lane * 4);
      ss += v[i].x * v[i].x + v[i].y * v[i].y + v[i].z * v[i].z + v[i].w * v[i].w;
    }
    ss = wave_sum(ss);
    float r = rsqrtf(ss * (1.f / D) + EPS);
#pragma unroll
    for (int i = 0; i < 8; ++i) {
      int col = i * 256 + lane * 4;
      float4 gg = *(const float4*)(g + col), s4 = *(const float4*)(sc + col), h4 = *(const float4*)(sh + col);
      float y0 = v[i].x * r * gg.x * (1.f + s4.x) + h4.x;
      float y1 = v[i].y * r * gg.y * (1.f + s4.y) + h4.y;
      float y2 = v[i].z * r * gg.z * (1.f + s4.z) + h4.z;
      float y3 = v[i].w * r * gg.w * (1.f + s4.w) + h4.w;
      uint2 o; o.x = pack2(y0, y1); o.y = pack2(y2, y3);
      *(uint2*)(H + (size_t)row * D + col) = o;
    }
  }
}

constexpr int BM = 256, BK = 64, HALF = 128, HT = HALF * BK;
DEVI int lds_byte(int r, int c) {
  int st = (r >> 4) * 2 + (c >> 5), rr = r & 15, cc = c & 31, ob = rr * 64 + cc * 2;
  return st * 1024 + (ob ^ (((ob >> 9) & 1) << 5));
}
DEVI void stage_rc(int b, int& R, int& C) {
  int st = b / 1024, sb = b % 1024, swz = sb ^ (((sb >> 9) & 1) << 5);
  R = (st >> 1) * 16 + swz / 64; C = (st & 1) * 32 + (swz % 64) / 2;
}

template <int MODE, int MF, bool FIRST = false, int LEFT = 0>
DEVI void gemm_phase(const bf16* __restrict__ A, const bf16* __restrict__ Bt, int Mr, int N, int K,
                     float* outF, bf16* outB, const float* gate_l  , float coef,
                     const float* xin_c = nullptr, const float* xin_l = nullptr, unsigned* flags = nullptr) {
  extern __shared__ __attribute__((aligned(16))) unsigned char g_lds[];
  bf16* shm = (bf16*)g_lds;
#define SA(b, h) (shm + ((b) * 2 + (h)) * HT)
#define SB(b, h) (shm + (4 + (b) * 2 + (h)) * HT)
#define STAGE(Pp, BASE, br, kt) do { const bf16* _gb = (BASE) + ((long)(br) * K + (long)(kt) * BK); \
    __builtin_amdgcn_global_load_lds((const unsigned*)(_gb + soff0), (unsigned*)((char*)(Pp) + gtid * 16), 16, 0, 0); \
    __builtin_amdgcn_global_load_lds((const unsigned*)(_gb + soff1), (unsigned*)((char*)(Pp) + gtid * 16 + 8192), 16, 0, 0); } while (0)
#define LDA(dst, b, h) for (int m = 0; m < MF; ++m) for (int k = 0; k < 2; ++k) \
    dst[m][k] = *reinterpret_cast<const bf16x8*>((char*)SA(b, h) + lds_byte(wr * (MF * 16) + m * 16 + fr, k * 32 + fq * 8))
#define LDB(dst, b, h) for (int n = 0; n < 2; ++n) for (int k = 0; k < 2; ++k) \
    dst[n][k] = *reinterpret_cast<const bf16x8*>((char*)SB(b, h) + lds_byte(wc * 32 + n * 16 + fr, k * 32 + fq * 8))
#define MMA(ai, bj, At_, Bt_) do { __builtin_amdgcn_s_setprio(1); \
    for (int m = 0; m < MF; ++m) for (int n = 0; n < 2; ++n) for (int k = 0; k < 2; ++k) \
      acc[ai][bj][m][n] = __builtin_amdgcn_mfma_f32_16x16x32_bf16(At_[m][k], Bt_[n][k], acc[ai][bj][m][n], 0, 0, 0); \
    __builtin_amdgcn_s_setprio(0); } while (0)
#define WAIT_V(n) asm volatile("s_waitcnt vmcnt(" #n ")" ::: "memory")
#define WAIT_L(n) asm volatile("s_waitcnt lgkmcnt(" #n ")" ::: "memory")
#define BAR __builtin_amdgcn_s_barrier()
#define SCHED __builtin_amdgcn_sched_barrier(0)
  constexpr int BMA = MF * 64, HALF_A = MF * 32;
  const int nM = Mr / BMA, nN = N / BM, nwg = nM * nN;
  const int gtid = otid(), gbid = obid(), ggd = ogdim();
  const int wid = gtid >> 6, lane = gtid & 63, wr = wid >> 2, wc = wid & 3, fr = lane & 15, fq = lane >> 4;
  const int nt = K / BK;
  unsigned soff0, soff1;
  { int _r, _c; stage_rc(gtid * 16, _r, _c); soff0 = (unsigned)(_r * K + _c); stage_rc(gtid * 16 + 8192, _r, _c); soff1 = (unsigned)(_r * K + _c); }
  const int nNa = (LEFT == 1) ? nN - 4 : nN;
  const int nwga = nM * nNa;
  const int ntiles = (LEFT == 1) ? nwga + 64 : (LEFT == 3 ? 32 : nwg);
  for (int vt = (LEFT == 3 ? ((gbid - 192) % ggd + ggd) % ggd : gbid); vt < ntiles; vt += ggd) {
    int pm, pn;
    if (LEFT == 3) { pm = 16 + (vt & 7); pn = nN - 4 + (vt >> 3); }
    else if (LEFT == 1 && vt >= nwga) { const int v2 = vt - nwga; pm = v2 & 15; pn = nNa + (v2 >> 4); }
    else {
      int wgid = vt;
      { int q = nwga / 8, r = nwga % 8, xcd = wgid % 8, off = wgid / 8;
        wgid = (xcd < r ? xcd * (q + 1) : r * (q + 1) + (xcd - r) * q) + off; }
      int nig = 8 * nNa, gid = wgid / nig, fm = gid * 8, gsz = min(nM - fm, 8);
      pm = fm + ((wgid % nig) % gsz); pn = (wgid % nig) / gsz;
    }
    const int brow = pm * BMA, bcol = pn * BM;
    f32x4 acc[2][2][MF][2];
#pragma unroll
    for (int a = 0; a < 2; ++a) for (int b = 0; b < 2; ++b) for (int m = 0; m < MF; ++m) for (int n = 0; n < 2; ++n) acc[a][b][m][n] = f32x4{0.f, 0.f, 0.f, 0.f};
    bf16x8 At[MF][2], B0[2][2], B1[2][2];
    STAGE(SB(0, 0), Bt, bcol, 0); STAGE(SA(0, 0), A, brow, 0);
    STAGE(SB(0, 1), Bt, bcol + HALF, 0); STAGE(SA(0, 1), A, brow + HALF_A, 0);
    if (wr == 1) BAR;
    WAIT_V(4); BAR;
    STAGE(SB(1, 0), Bt, bcol, 1); STAGE(SA(1, 0), A, brow, 1); STAGE(SB(1, 1), Bt, bcol + HALF, 1);
    WAIT_V(6); BAR;
    for (int t = 0; t < nt - 2; t += 2) {
      if (LEFT == 2 && t == 78 && pm >= 16) {
        if (gtid == 0) {
          unsigned sp = 0;
          while (xb_ld(flags + (pm - 16)) < 4u && ++sp < (1u << 22)) __builtin_amdgcn_s_sleep(2);
          __builtin_amdgcn_fence(__ATOMIC_ACQUIRE, "agent");
          asm volatile("s_waitcnt vmcnt(0)" ::: "memory");
        }
        BAR;
      }
      LDB(B0, 0, 0); SCHED; LDA(At, 0, 0); STAGE(SA(1, 1), A, brow + HALF_A, t + 1);
      WAIT_L(8); BAR; WAIT_L(0); MMA(0, 0, At, B0); BAR; SCHED;
      LDB(B1, 0, 1); STAGE(SB(0, 0), Bt, bcol, t + 2);
      BAR; WAIT_L(0); MMA(0, 1, At, B1); BAR;
      LDA(At, 0, 1); STAGE(SA(0, 0), A, brow, t + 2);
      BAR; WAIT_L(0); MMA(1, 0, At, B0); BAR; SCHED;
      STAGE(SB(0, 1), Bt, bcol + HALF, t + 2);
      WAIT_V(6); BAR; MMA(1, 1, At, B1); BAR;
      LDB(B0, 1, 0); SCHED; LDA(At, 1, 0); STAGE(SA(0, 1), A, brow + HALF_A, t + 2);
      WAIT_L(8); BAR; WAIT_L(0); MMA(0, 0, At, B0); BAR; SCHED;
      LDB(B1, 1, 1); STAGE(SB(1, 0), Bt, bcol, t + 3);
      BAR; WAIT_L(0); MMA(0, 1, At, B1); BAR;
      LDA(At, 1, 1); STAGE(SA(1, 0), A, brow, t + 3);
      BAR; WAIT_L(0); MMA(1, 0, At, B0); BAR; SCHED;
      STAGE(SB(1, 1), Bt, bcol + HALF, t + 3);
      WAIT_V(6); BAR; MMA(1, 1, At, B1); BAR;
    }
    { LDB(B0, 0, 0); LDA(At, 0, 0); STAGE(SA(1, 1), A, brow + HALF_A, nt - 1);
      BAR; WAIT_L(0); MMA(0, 0, At, B0); BAR;
      LDB(B1, 0, 1); BAR; WAIT_L(0); MMA(0, 1, At, B1); BAR;
      LDA(At, 0, 1); WAIT_V(4); BAR; WAIT_L(0); MMA(1, 0, At, B0); MMA(1, 1, At, B1); BAR; }
    { LDB(B0, 1, 0); LDA(At, 1, 0); WAIT_V(2); BAR; WAIT_L(0); MMA(0, 0, At, B0); BAR;
      LDB(B1, 1, 1); WAIT_V(0); BAR; WAIT_L(0); MMA(0, 1, At, B1); BAR;
      LDA(At, 1, 1); BAR; WAIT_L(0); MMA(1, 0, At, B0); MMA(1, 1, At, B1); BAR; }
    if (wr == 0) BAR;
    if (MODE == 0) {
#pragma unroll
      for (int ai = 0; ai < 2; ++ai) for (int bj = 0; bj < 2; ++bj) for (int m = 0; m < MF; ++m) for (int n = 0; n < 2; ++n) for (int j = 0; j < 4; ++j)
        outF[(size_t)(brow + ai * HALF_A + wr * (MF * 16) + m * 16 + fq * 4 + j) * N + (bcol + bj * HALF + wc * 32 + n * 16 + fr)] = acc[ai][bj][m][n][j];
    } else if (MODE == 1) {
      const int ldo = N / 2;
#pragma unroll
      for (int ai = 0; ai < 2; ++ai) for (int bj = 0; bj < 2; ++bj) for (int m = 0; m < MF; ++m) for (int j = 0; j < 4; ++j) {
        float gv = acc[ai][bj][m][0][j], uv = acc[ai][bj][m][1][j];
        float r = gv / (1.f + __expf(-gv)) * uv;
        size_t row = brow + ai * HALF_A + wr * (MF * 16) + m * 16 + fq * 4 + j;
        int col = (bcol + bj * HALF + wc * 32) / 2 + fr;
        reinterpret_cast<unsigned short*>(outB)[row * ldo + col] = f2bf(r);
      }
    } else {
#pragma unroll
      for (int ai = 0; ai < 2; ++ai) for (int m = 0; m < MF; ++m) for (int j = 0; j < 4; ++j) {
        const int row = brow + ai * HALF_A + wr * (MF * 16) + m * 16 + fq * 4 + j;
        const int ci = row < MC ? 0 : 1 + ((row - MC) >> 10);
        const float* gate = gate_l + (size_t)ci * NMODW;
#pragma unroll
        for (int bj = 0; bj < 2; ++bj) for (int n = 0; n < 2; ++n) {
          const int col = bcol + bj * HALF + wc * 32 + n * 16 + fr;
          float* xp = outF + (size_t)row * N + col;
          const float xold = !FIRST ? *xp : (row < MC ? xin_c[(size_t)row * N + col] : xin_l[(size_t)(row - MC) * N + col]);
          *xp = xold + gate[col] * coef * acc[ai][bj][m][n][j];
        }
      }
    }
    WAIT_V(0);
    if (LEFT == 3) {
      BAR;
      if (gtid == 0) {
        __builtin_amdgcn_fence(__ATOMIC_RELEASE, "agent");
        asm volatile("s_waitcnt vmcnt(0)" ::: "memory");
        (void)xb_add(flags + (pm - 16), 1u);
      }
    }
  }
#undef SA
#undef SB
#undef STAGE
#undef LDA
#undef LDB
#undef MMA
}

DEVI void transpose16(const float* __restrict__ src, size_t srow, int col, bf16* __restrict__ dst, float* __restrict__ outp, size_t orow) {
  float v[16];
#pragma unroll
  for (int i = 0; i < 16; ++i) v[i] = src[(size_t)i * srow + col];
  if (outp) {
#pragma unroll
    for (int i = 0; i < 16; ++i) outp[(size_t)i * orow] = v[i];
  }
  uint4 a, b;
  a.x = pack2(v[0], v[1]); a.y = pack2(v[2], v[3]); a.z = pack2(v[4], v[5]); a.w = pack2(v[6], v[7]);
  b.x = pack2(v[8], v[9]); b.y = pack2(v[10], v[11]); b.z = pack2(v[12], v[13]); b.w = pack2(v[14], v[15]);
  *(uint4*)dst = a; *(uint4*)(dst + 8) = b;
}

DEVI void prep_item(int l, int item) {
  P p; LOADP(ws); LOADP(out); LOADP(gqn); LOADP(gkn); LOADP(dqn); LOADP(dkn); LOADP(cgk); LOADP(cgv); LOADP(cdk); LOADP(cdv);
  const int tid = otid(), lane = tid & 63, wave = tid >> 6;
  const float* PROJ = (const float*)(p.ws + WS_PROJ);
  unsigned short* QG = (unsigned short*)(p.ws + WS_QG);
  unsigned short* KGC = (unsigned short*)(p.ws + WS_KGC);
  unsigned short* KGL = (unsigned short*)(p.ws + WS_KGL);
  bf16* VGC = (bf16*)(p.ws + WS_VGC);
  bf16* VGL = (bf16*)(p.ws + WS_VGL);
  unsigned short* QDb = (unsigned short*)(p.ws + WS_QD);
  unsigned short* KDC = (unsigned short*)(p.ws + WS_KDC);
  unsigned short* KDL = (unsigned short*)(p.ws + WS_KDL);
  bf16* VDC = (bf16*)(p.ws + WS_VDC);
  bf16* VDL = (bf16*)(p.ws + WS_VDL);
  {
    if (item < 384) {
      const int r0 = item * 16;
      const bool lat = r0 >= MC;
      const int b = lat ? (r0 - MC) >> 10 : r0 >> 8;
      const int t0 = lat ? (r0 - MC) & 1023 : r0 & 255;
      {
        const int rw = r0 + wave * 2, tw = t0 + wave * 2;
        float xg0[2][8], xg1[2][8], xd[2][24];
#pragma unroll
        for (int i = 0; i < 2; ++i) {
          const float* base = PROJ + (size_t)(rw + i) * INW;
#pragma unroll
          for (int hh = 0; hh < 8; ++hh) { xg0[i][hh] = base[2560 + hh * 128 + lane]; xg1[i][hh] = base[2560 + hh * 128 + 64 + lane]; }
#pragma unroll
          for (int u = 0; u < 24; ++u) xd[i][u] = base[3840 + u * 64 + lane];
        }
        const float gq0 = p.gqn[l * 128 + lane], gq1 = p.gqn[l * 128 + 64 + lane];
        const float gk0 = p.gkn[l * 128 + lane], gk1 = p.gkn[l * 128 + 64 + lane];
        const float gdq = p.dqn[l * 64 + lane], gdk = p.dkn[l * 64 + lane];
        const float invg = exp2f(-(float)(lane & 31) * (13.287712379549449f / 32.f));
        const float invd = exp2f(-(float)(lane & 15) * (13.287712379549449f / 16.f));
#pragma unroll
        for (int i = 0; i < 2; ++i) {
          const int row = rw + i, t = tw + i;
          const float pr = (float)(t >> 6), pc = (float)(t & 63);
          float c0 = 1.f, s0 = 0.f, c1 = 1.f, s1 = 0.f, cd = 1.f, sd = 0.f;
          if (lat) {
            float a0 = pr * invg, a1 = pc * invg, ad = ((lane >> 5) ? pc : pr) * invd;
            c0 = __cosf(a0); s0 = __sinf(a0); c1 = __cosf(a1); s1 = __sinf(a1); cd = __cosf(ad); sd = __sinf(ad);
            if (lane < 32) { s0 = -s0; s1 = -s1; }
            if (!((lane >> 4) & 1)) sd = -sd;
          }
#pragma unroll
          for (int hh = 0; hh < 8; ++hh) {
            float x0 = xg0[i][hh], x1 = xg1[i][hh];
            float ss = wave_sum(x0 * x0 + x1 * x1);
            float r = rsqrtf(ss * (1.f / 128.f) + EPS);
            float y0 = x0 * r * (hh < 6 ? gq0 : gk0), y1 = x1 * r * (hh < 6 ? gq1 : gk1);
            if (!lat && hh >= 6) {
              float* o = p.out + O_GK + ((size_t)(b * 2 + l) * 256 + t) * 256 + (hh - 6) * 128;
              o[lane] = y0; o[64 + lane] = y1;
            }
            if (lat) {
              float p0 = __shfl_xor(y0, 32), p1 = __shfl_xor(y1, 32);
              y0 = y0 * c0 + p0 * s0; y1 = y1 * c1 + p1 * s1;
            }
            unsigned short* dst;
            if (hh < 6) dst = QG + (size_t)row * 768 + hh * 128;
            else if (!lat) dst = KGC + (size_t)row * 256 + (hh - 6) * 128;
            else dst = KGL + ((size_t)b * 1280 + 256 + t) * 256 + (hh - 6) * 128;
            dst[lane] = f2bf(y0); dst[64 + lane] = f2bf(y1);
          }
#pragma unroll
          for (int u = 0; u < 24; ++u) {
            float x = xd[i][u];
            float ss = wave_sum(x * x);
            float r = rsqrtf(ss * (1.f / 64.f) + EPS);
            float y = x * r * (u < 12 ? gdq : gdk);
            if (!lat && u >= 12) p.out[O_DK + ((size_t)(b * 2 + l) * 256 + t) * 768 + (u - 12) * 64 + lane] = y;
            if (lat) { float pp = __shfl_xor(y, 16); y = y * cd + pp * sd; }
            unsigned short* dst;
            if (u < 12) dst = QDb + (size_t)row * 768 + u * 64;
            else if (!lat) dst = KDC + (size_t)row * 768 + (u - 12) * 64;
            else dst = KDL + ((size_t)b * 1280 + 256 + t) * 768 + (u - 12) * 64;
            dst[lane] = f2bf(y);
          }
        }
      }
      for (int it = 0; it < 2; ++it) {
        int col = tid + it * NT;
        const float* src = PROJ + (size_t)r0 * INW;
        if (col < 256) {
          int h = col >> 7, d = col & 127;
          bf16* dst = lat ? VGL + ((size_t)(b * 2 + h) * 128 + d) * 1280 + 256 + t0 : VGC + ((size_t)(b * 2 + h) * 128 + d) * 256 + t0;
          float* o = lat ? nullptr : p.out + O_GV + ((size_t)(b * 2 + l) * 256 + t0) * 256 + col;
          transpose16(src, INW, 3584 + col, dst, o, 256);
        } else {
          int c2 = col - 256, h = c2 >> 7, d = c2 & 127;
          bf16* dst = lat ? VDL + ((size_t)(b * 6 + h) * 128 + d) * 1280 + 256 + t0 : VDC + ((size_t)(b * 6 + h) * 128 + d) * 256 + t0;
          float* o = lat ? nullptr : p.out + O_DV + ((size_t)(b * 2 + l) * 256 + t0) * 768 + c2;
          transpose16(src, INW, 5376 + c2, dst, o, 768);
        }
      }
    } else {
      const int ci = item - 384, b = ci >> 4, s0 = (ci & 15) * 16;
      const float* ck = p.cgk + ((size_t)(b * 2 + l) * 256 + s0) * 256;
      for (int e = tid; e < 16 * 256; e += NT) KGL[((size_t)b * 1280 + s0) * 256 + e] = f2bf(ck[e]);
      const float* dk = p.cdk + ((size_t)(b * 2 + l) * 256 + s0) * 768;
      for (int e = tid; e < 16 * 768; e += NT) KDL[((size_t)b * 1280 + s0) * 768 + e] = f2bf(dk[e]);
      for (int it = 0; it < 2; ++it) {
        int col = tid + it * NT;
        if (col < 256) {
          int h = col >> 7, d = col & 127;
          transpose16(p.cgv + ((size_t)(b * 2 + l) * 256 + s0) * 256, 256, col, VGL + ((size_t)(b * 2 + h) * 128 + d) * 1280 + s0, nullptr, 0);
        } else {
          int c2 = col - 256, h = c2 >> 7, d = c2 & 127;
          transpose16(p.cdv + ((size_t)(b * 2 + l) * 256 + s0) * 768, 768, c2, VDL + ((size_t)(b * 6 + h) * 128 + d) * 1280 + s0, nullptr, 0);
        }
      }
    }
  }
}

constexpr int A_KB = 64 * 136 * 2;
constexpr int A_VB = 128 * 72 * 2;
constexpr int A_K0 = 0, A_V0 = 2 * A_KB;
static_assert(2 * A_KB + 2 * A_VB <= LDS_BYTES, "attn lds");
template <int DQK>
DEVI void attn_wave(const bf16* __restrict__ Qp, int qstride, const bf16* __restrict__ Kp, int kstride,
                    const bf16* __restrict__ Vt, int S, float scale_log2, f32x4 (&o)[8], int tid) {
  extern __shared__ __attribute__((aligned(16))) unsigned char g_lds[];
  const int lane = tid & 63, fr = lane & 15, fq = lane >> 4;
  constexpr int NKS = DQK / 32;
  constexpr int KCH = DQK / 8;
  constexpr int NKL = (64 * KCH) / NT;
  bf16x8 qf[NKS];
#pragma unroll
  for (int ks = 0; ks < NKS; ++ks) qf[ks] = *(const bf16x8*)(Qp + (size_t)fr * qstride + ks * 32 + fq * 8);
#pragma unroll
  for (int t = 0; t < 8; ++t) o[t] = f32x4{0.f, 0.f, 0.f, 0.f};
  float m = -1e30f, lsum = 0.f;
  int kgo[NKL], klo[NKL];
#pragma unroll
  for (int i = 0; i < NKL; ++i) {
    int cidx = tid + i * NT, key = cidx / KCH, c8 = cidx % KCH;
    int lrow = ((key >> 5) * 2 + ((key >> 2) & 1)) * 16 + ((key >> 3) & 3) * 4 + (key & 3);
    kgo[i] = key * kstride + c8 * 8;
    klo[i] = lrow * 272 + c8 * 16;
  }
  int vgo[2], vlo[2];
#pragma unroll
  for (int i = 0; i < 2; ++i) {
    int cidx = tid + i * NT, dv = cidx >> 3, c8 = cidx & 7;
    vgo[i] = dv * S + c8 * 8;
    vlo[i] = dv * 144 + c8 * 16;
  }
  uint4 kr[NKL], vr[2];
#pragma unroll
  for (int i = 0; i < NKL; ++i) kr[i] = *(const uint4*)(Kp + kgo[i]);
#pragma unroll
  for (int i = 0; i < 2; ++i) vr[i] = *(const uint4*)(Vt + vgo[i]);
#pragma unroll
  for (int i = 0; i < NKL; ++i) *(uint4*)(g_lds + A_K0 + klo[i]) = kr[i];
#pragma unroll
  for (int i = 0; i < 2; ++i) *(uint4*)(g_lds + A_V0 + vlo[i]) = vr[i];
  __syncthreads();
  const int nst = S / 64;
  for (int st = 0; st < nst; ++st) {
    const int cur = st & 1;
    if (st + 1 < nst) {
      const bf16* kn = Kp + (size_t)(st + 1) * 64 * kstride;
      const bf16* vn = Vt + (st + 1) * 64;
#pragma unroll
      for (int i = 0; i < NKL; ++i) kr[i] = *(const uint4*)(kn + kgo[i]);
#pragma unroll
      for (int i = 0; i < 2; ++i) vr[i] = *(const uint4*)(vn + vgo[i]);
    }
    const unsigned char* kb = g_lds + A_K0 + cur * A_KB;
    const unsigned char* vb = g_lds + A_V0 + cur * A_VB;
    f32x4 sc[4];
#pragma unroll
    for (int a = 0; a < 4; ++a) {
      f32x4 acc = f32x4{0.f, 0.f, 0.f, 0.f};
#pragma unroll
      for (int ks = 0; ks < NKS; ++ks) {
        bf16x8 kf = *(const bf16x8*)(kb + (a * 16 + fr) * 272 + ks * 64 + fq * 16);
        acc = __builtin_amdgcn_mfma_f32_16x16x32_bf16(kf, qf[ks], acc, 0, 0, 0);
      }
      sc[a] = acc;
    }
    float mx = -1e30f;
#pragma unroll
    for (int a = 0; a < 4; ++a)
#pragma unroll
      for (int j = 0; j < 4; ++j) { sc[a][j] *= scale_log2; mx = fmaxf(mx, sc[a][j]); }
    mx = fmaxf(mx, __shfl_xor(mx, 16));
    mx = fmaxf(mx, __shfl_xor(mx, 32));
    float mn = fmaxf(m, mx);
    float alpha = exp2f(m - mn);
    m = mn;
    float ps = 0.f;
#pragma unroll
    for (int a = 0; a < 4; ++a)
#pragma unroll
      for (int j = 0; j < 4; ++j) { sc[a][j] = exp2f(sc[a][j] - mn); ps += sc[a][j]; }
    lsum = lsum * alpha + ps;
#pragma unroll
    for (int t = 0; t < 8; ++t)
#pragma unroll
      for (int j = 0; j < 4; ++j) o[t][j] *= alpha;
#pragma unroll
    for (int pp = 0; pp < 2; ++pp) {
      union { bf16x8 v; unsigned u[4]; } pb;
      pb.u[0] = pack2(sc[2 * pp][0], sc[2 * pp][1]); pb.u[1] = pack2(sc[2 * pp][2], sc[2 * pp][3]);
      pb.u[2] = pack2(sc[2 * pp + 1][0], sc[2 * pp + 1][1]); pb.u[3] = pack2(sc[2 * pp + 1][2], sc[2 * pp + 1][3]);
#pragma unroll
      for (int t = 0; t < 8; ++t) {
        bf16x8 vf = *(const bf16x8*)(vb + (t * 16 + fr) * 144 + pp * 64 + fq * 16);
        o[t] = __builtin_amdgcn_mfma_f32_16x16x32_bf16(vf, pb.v, o[t], 0, 0, 0);
      }
    }
    if (st + 1 < nst) {
      unsigned char* kw = g_lds + A_K0 + (cur ^ 1) * A_KB;
      unsigned char* vw = g_lds + A_V0 + (cur ^ 1) * A_VB;
#pragma unroll
      for (int i = 0; i < NKL; ++i) *(uint4*)(kw + klo[i]) = kr[i];
#pragma unroll
      for (int i = 0; i < 2; ++i) *(uint4*)(vw + vlo[i]) = vr[i];
    }
    __syncthreads();
  }
  lsum += __shfl_xor(lsum, 16);
  lsum += __shfl_xor(lsum, 32);
  float inv = 1.f / lsum;
#pragma unroll
  for (int t = 0; t < 8; ++t)
#pragma unroll
    for (int j = 0; j < 4; ++j) o[t][j] *= inv;
}

DEVI void attn_dual(const bf16* __restrict__ Qp, int qstride, const bf16* __restrict__ Kp, int kstride,
                    const bf16* __restrict__ Vt, int S, float scale_log2, f32x4 (&o0)[8], f32x4 (&o1)[8], int tid) {
  extern __shared__ __attribute__((aligned(16))) unsigned char g_lds[];
  const int lane = tid & 63, fr = lane & 15, fq = lane >> 4;
  bf16x8 qf[4];
#pragma unroll
  for (int ks = 0; ks < 4; ++ks) qf[ks] = *(const bf16x8*)(Qp + (size_t)fr * qstride + ks * 32 + fq * 8);
#pragma unroll
  for (int t = 0; t < 8; ++t) { o0[t] = f32x4{0.f, 0.f, 0.f, 0.f}; o1[t] = f32x4{0.f, 0.f, 0.f, 0.f}; }
  float m0 = -1e30f, l0 = 0.f, m1 = -1e30f, l1 = 0.f;
  int kgo[2], klo[2];
#pragma unroll
  for (int i = 0; i < 2; ++i) {
    int cidx = tid + i * NT, key = cidx >> 4, c8 = cidx & 15;
    int lrow = ((key >> 5) * 2 + ((key >> 2) & 1)) * 16 + ((key >> 3) & 3) * 4 + (key & 3);
    kgo[i] = key * kstride + c8 * 8;
    klo[i] = lrow * 272 + c8 * 16;
  }
  int vgo[2], vlo[2];
#pragma unroll
  for (int i = 0; i < 2; ++i) {
    int cidx = tid + i * NT, dv = cidx >> 3, c8 = cidx & 7;
    vgo[i] = dv * S + c8 * 8;
    vlo[i] = dv * 144 + c8 * 16;
  }
  uint4 kr0 = *(const uint4*)(Kp + kgo[0]), kr1 = *(const uint4*)(Kp + kgo[1]);
  uint4 vr0 = *(const uint4*)(Vt + vgo[0]), vr1 = *(const uint4*)(Vt + vgo[1]);
  *(uint4*)(g_lds + A_K0 + klo[0]) = kr0; *(uint4*)(g_lds + A_K0 + klo[1]) = kr1;
  *(uint4*)(g_lds + A_V0 + vlo[0]) = vr0; *(uint4*)(g_lds + A_V0 + vlo[1]) = vr1;
  __syncthreads();
  const int nst = S / 64;
  for (int st = 0; st < nst; ++st) {
    const int cur = st & 1;
    if (st + 1 < nst) {
      const bf16* kn = Kp + (size_t)(st + 1) * 64 * kstride;
      const bf16* vn = Vt + (st + 1) * 64;
      kr0 = *(const uint4*)(kn + kgo[0]); kr1 = *(const uint4*)(kn + kgo[1]);
      vr0 = *(const uint4*)(vn + vgo[0]); vr1 = *(const uint4*)(vn + vgo[1]);
    }
    const unsigned char* kb = g_lds + A_K0 + cur * A_KB;
    const unsigned char* vb = g_lds + A_V0 + cur * A_VB;
    f32x4 s0[4], s1[4];
#pragma unroll
    for (int a = 0; a < 4; ++a) {
      f32x4 a0 = f32x4{0.f, 0.f, 0.f, 0.f}, a1 = a0;
#pragma unroll
      for (int ks = 0; ks < 2; ++ks) {
        bf16x8 k0 = *(const bf16x8*)(kb + (a * 16 + fr) * 272 + ks * 64 + fq * 16);
        bf16x8 k1 = *(const bf16x8*)(kb + (a * 16 + fr) * 272 + (ks + 2) * 64 + fq * 16);
        a0 = __builtin_amdgcn_mfma_f32_16x16x32_bf16(k0, qf[ks], a0, 0, 0, 0);
        a1 = __builtin_amdgcn_mfma_f32_16x16x32_bf16(k1, qf[ks + 2], a1, 0, 0, 0);
      }
      s0[a] = a0; s1[a] = a1;
    }
    float x0 = -1e30f, x1 = -1e30f;
#pragma unroll
    for (int a = 0; a < 4; ++a)
#pragma unroll
      for (int j = 0; j < 4; ++j) {
        s0[a][j] *= scale_log2; x0 = fmaxf(x0, s0[a][j]);
        s1[a][j] *= scale_log2; x1 = fmaxf(x1, s1[a][j]);
      }
    x0 = fmaxf(x0, __shfl_xor(x0, 16)); x0 = fmaxf(x0, __shfl_xor(x0, 32));
    x1 = fmaxf(x1, __shfl_xor(x1, 16)); x1 = fmaxf(x1, __shfl_xor(x1, 32));
    const float n0 = fmaxf(m0, x0), n1 = fmaxf(m1, x1);
    const float al0 = exp2f(m0 - n0), al1 = exp2f(m1 - n1);
    m0 = n0; m1 = n1;
    float p0 = 0.f, p1 = 0.f;
#pragma unroll
    for (int a = 0; a < 4; ++a)
#pragma unroll
      for (int j = 0; j < 4; ++j) {
        s0[a][j] = exp2f(s0[a][j] - n0); p0 += s0[a][j];
        s1[a][j] = exp2f(s1[a][j] - n1); p1 += s1[a][j];
      }
    l0 = l0 * al0 + p0; l1 = l1 * al1 + p1;
#pragma unroll
    for (int t = 0; t < 8; ++t)
#pragma unroll
      for (int j = 0; j < 4; ++j) { o0[t][j] *= al0; o1[t][j] *= al1; }
#pragma unroll
    for (int pp = 0; pp < 2; ++pp) {
      typedef unsigned u32x4_t __attribute__((ext_vector_type(4)));
      const u32x4_t w0 = {pack2(s0[2 * pp][0], s0[2 * pp][1]), pack2(s0[2 * pp][2], s0[2 * pp][3]),
                          pack2(s0[2 * pp + 1][0], s0[2 * pp + 1][1]), pack2(s0[2 * pp + 1][2], s0[2 * pp + 1][3])};
      const u32x4_t w1 = {pack2(s1[2 * pp][0], s1[2 * pp][1]), pack2(s1[2 * pp][2], s1[2 * pp][3]),
                          pack2(s1[2 * pp + 1][0], s1[2 * pp + 1][1]), pack2(s1[2 * pp + 1][2], s1[2 * pp + 1][3])};
      struct { bf16x8 v; } b0 = {__builtin_bit_cast(bf16x8, w0)}, b1 = {__builtin_bit_cast(bf16x8, w1)};
#pragma unroll
      for (int t = 0; t < 8; ++t) {
        bf16x8 vf = *(const bf16x8*)(vb + (t * 16 + fr) * 144 + pp * 64 + fq * 16);
        o0[t] = __builtin_amdgcn_mfma_f32_16x16x32_bf16(vf, b0.v, o0[t], 0, 0, 0);
        o1[t] = __builtin_amdgcn_mfma_f32_16x16x32_bf16(vf, b1.v, o1[t], 0, 0, 0);
      }
    }
    if (st + 1 < nst) {
      unsigned char* kw = g_lds + A_K0 + (cur ^ 1) * A_KB;
      unsigned char* vw = g_lds + A_V0 + (cur ^ 1) * A_VB;
      *(uint4*)(kw + klo[0]) = kr0; *(uint4*)(kw + klo[1]) = kr1;
      *(uint4*)(vw + vlo[0]) = vr0; *(uint4*)(vw + vlo[1]) = vr1;
    }
    __syncthreads();
  }
  l0 += __shfl_xor(l0, 16); l0 += __shfl_xor(l0, 32);
  l1 += __shfl_xor(l1, 16); l1 += __shfl_xor(l1, 32);
  const float i0 = 1.f / l0, i1 = 1.f / l1;
#pragma unroll
  for (int t = 0; t < 8; ++t)
#pragma unroll
    for (int j = 0; j < 4; ++j) { o0[t][j] *= i0; o1[t][j] *= i1; }
}

DEVI void attn_pair(const bf16* __restrict__ Qp, int qstride, const bf16* __restrict__ Kp, int kstride,
                    const bf16* __restrict__ Vt, int S, float scale_log2, f32x4 (&o0)[8], f32x4 (&o1)[8], int tid) {
  extern __shared__ __attribute__((aligned(16))) unsigned char g_lds[];
  const int lane = tid & 63, fr = lane & 15, fq = lane >> 4;
  bf16x8 qa[4], qb[4];
#pragma unroll
  for (int ks = 0; ks < 4; ++ks) {
    qa[ks] = *(const bf16x8*)(Qp + (size_t)fr * qstride + ks * 32 + fq * 8);
    qb[ks] = *(const bf16x8*)(Qp + (size_t)(16 + fr) * qstride + ks * 32 + fq * 8);
  }
#pragma unroll
  for (int t = 0; t < 8; ++t) { o0[t] = f32x4{0.f, 0.f, 0.f, 0.f}; o1[t] = f32x4{0.f, 0.f, 0.f, 0.f}; }
  float m0 = -1e30f, l0 = 0.f, m1 = -1e30f, l1 = 0.f;
  int kgo[2], klo[2];
#pragma unroll
  for (int i = 0; i < 2; ++i) {
    int cidx = tid + i * NT, key = cidx >> 4, c8 = cidx & 15;
    int lrow = ((key >> 5) * 2 + ((key >> 2) & 1)) * 16 + ((key >> 3) & 3) * 4 + (key & 3);
    kgo[i] = key * kstride + c8 * 8;
    klo[i] = lrow * 272 + c8 * 16;
  }
  int vgo[2], vlo[2];
#pragma unroll
  for (int i = 0; i < 2; ++i) {
    int cidx = tid + i * NT, dv = cidx >> 3, c8 = cidx & 7;
    vgo[i] = dv * S + c8 * 8;
    vlo[i] = dv * 144 + c8 * 16;
  }
  uint4 kr0 = *(const uint4*)(Kp + kgo[0]), kr1 = *(const uint4*)(Kp + kgo[1]);
  uint4 vr0 = *(const uint4*)(Vt + vgo[0]), vr1 = *(const uint4*)(Vt + vgo[1]);
  *(uint4*)(g_lds + A_K0 + klo[0]) = kr0; *(uint4*)(g_lds + A_K0 + klo[1]) = kr1;
  *(uint4*)(g_lds + A_V0 + vlo[0]) = vr0; *(uint4*)(g_lds + A_V0 + vlo[1]) = vr1;
  __syncthreads();
  const int nst = S / 64;
  for (int st = 0; st < nst; ++st) {
    const int cur = st & 1;
    if (st + 1 < nst) {
      const bf16* kn = Kp + (size_t)(st + 1) * 64 * kstride;
      const bf16* vn = Vt + (st + 1) * 64;
      kr0 = *(const uint4*)(kn + kgo[0]); kr1 = *(const uint4*)(kn + kgo[1]);
      vr0 = *(const uint4*)(vn + vgo[0]); vr1 = *(const uint4*)(vn + vgo[1]);
    }
    const unsigned char* kb = g_lds + A_K0 + cur * A_KB;
    const unsigned char* vb = g_lds + A_V0 + cur * A_VB;
    f32x4 s0[4], s1[4];
#pragma unroll
    for (int a = 0; a < 4; ++a) {
      f32x4 a0 = f32x4{0.f, 0.f, 0.f, 0.f}, a1 = a0;
#pragma unroll
      for (int ks = 0; ks < 4; ++ks) {
        bf16x8 k0 = *(const bf16x8*)(kb + (a * 16 + fr) * 272 + ks * 64 + fq * 16);
        a0 = __builtin_amdgcn_mfma_f32_16x16x32_bf16(k0, qa[ks], a0, 0, 0, 0);
        a1 = __builtin_amdgcn_mfma_f32_16x16x32_bf16(k0, qb[ks], a1, 0, 0, 0);
      }
      s0[a] = a0; s1[a] = a1;
    }
    float x0 = -1e30f, x1 = -1e30f;
#pragma unroll
    for (int a = 0; a < 4; ++a)
#pragma unroll
      for (int j = 0; j < 4; ++j) {
        s0[a][j] *= scale_log2; x0 = fmaxf(x0, s0[a][j]);
        s1[a][j] *= scale_log2; x1 = fmaxf(x1, s1[a][j]);
      }
    x0 = fmaxf(x0, __shfl_xor(x0, 16)); x0 = fmaxf(x0, __shfl_xor(x0, 32));
    x1 = fmaxf(x1, __shfl_xor(x1, 16)); x1 = fmaxf(x1, __shfl_xor(x1, 32));
    const float n0 = fmaxf(m0, x0), n1 = fmaxf(m1, x1);
    const float al0 = exp2f(m0 - n0), al1 = exp2f(m1 - n1);
    m0 = n0; m1 = n1;
    float p0 = 0.f, p1 = 0.f;
#pragma unroll
    for (int a = 0; a < 4; ++a)
#pragma unroll
      for (int j = 0; j < 4; ++j) {
        s0[a][j] = exp2f(s0[a][j] - n0); p0 += s0[a][j];
        s1[a][j] = exp2f(s1[a][j] - n1); p1 += s1[a][j];
      }
    l0 = l0 * al0 + p0; l1 = l1 * al1 + p1;
#pragma unroll
    for (int t = 0; t < 8; ++t)
#pragma unroll
      for (int j = 0; j < 4; ++j) { o0[t][j] *= al0; o1[t][j] *= al1; }
#pragma unroll
    for (int pp = 0; pp < 2; ++pp) {
      typedef unsigned u32x4_t __attribute__((ext_vector_type(4)));
      const u32x4_t w0 = {pack2(s0[2 * pp][0], s0[2 * pp][1]), pack2(s0[2 * pp][2], s0[2 * pp][3]),
                          pack2(s0[2 * pp + 1][0], s0[2 * pp + 1][1]), pack2(s0[2 * pp + 1][2], s0[2 * pp + 1][3])};
      const u32x4_t w1 = {pack2(s1[2 * pp][0], s1[2 * pp][1]), pack2(s1[2 * pp][2], s1[2 * pp][3]),
                          pack2(s1[2 * pp + 1][0], s1[2 * pp + 1][1]), pack2(s1[2 * pp + 1][2], s1[2 * pp + 1][3])};
      struct { bf16x8 v; } b0 = {__builtin_bit_cast(bf16x8, w0)}, b1 = {__builtin_bit_cast(bf16x8, w1)};
#pragma unroll
      for (int t = 0; t < 8; ++t) {
        bf16x8 vf = *(const bf16x8*)(vb + (t * 16 + fr) * 144 + pp * 64 + fq * 16);
        o0[t] = __builtin_amdgcn_mfma_f32_16x16x32_bf16(vf, b0.v, o0[t], 0, 0, 0);
        o1[t] = __builtin_amdgcn_mfma_f32_16x16x32_bf16(vf, b1.v, o1[t], 0, 0, 0);
      }
    }
    if (st + 1 < nst) {
      unsigned char* kw = g_lds + A_K0 + (cur ^ 1) * A_KB;
      unsigned char* vw = g_lds + A_V0 + (cur ^ 1) * A_VB;
      *(uint4*)(kw + klo[0]) = kr0; *(uint4*)(kw + klo[1]) = kr1;
      *(uint4*)(vw + vlo[0]) = vr0; *(uint4*)(vw + vlo[1]) = vr1;
    }
    __syncthreads();
  }
  l0 += __shfl_xor(l0, 16); l0 += __shfl_xor(l0, 32);
  l1 += __shfl_xor(l1, 16); l1 += __shfl_xor(l1, 32);
  const float i0 = 1.f / l0, i1 = 1.f / l1;
#pragma unroll
  for (int t = 0; t < 8; ++t)
#pragma unroll
    for (int j = 0; j < 4; ++j) { o0[t][j] *= i0; o1[t][j] *= i1; }
}

DEVI void attn_item(int l, int ai) {
  P p; LOADP(ws); LOADP(dlam); LOADP(dsub);
  const int tid = otid(), lane = tid & 63, wave = tid >> 6, fr = lane & 15, fq = lane >> 4;
  bf16* MIX = (bf16*)(p.ws + WS_MIX);
  bool lat, diff; int b, h, qb;
  if (ai < 96) { lat = true; diff = true; b = ai / 48; h = (ai % 48) / 8; qb = ai % 8; }
  else if (ai < 144) { lat = true; diff = false; int r = ai - 96; b = r / 24; h = (r % 24) / 4; qb = r % 4; }
  else if (ai < 336) { lat = false; diff = true; int r = ai - 144; b = r / 12; h = (r % 12) / 2; qb = r % 2; }
  else { lat = false; diff = false; int r = ai - 336; b = r / 6; h = r % 6; qb = 0; }
  const int S = lat ? 1280 : 256;
  const int rowbase = lat ? MC + b * 1024 : b * 256;
  const int q0 = diff ? qb * 128 + wave * 16 : qb * 256 + wave * 32;
  const size_t row = (size_t)rowbase + q0;
  const float LOG2E = 1.4426950408889634f;
  if (!diff) {
    const bf16* Q = (const bf16*)(p.ws + WS_QG) + row * 768 + h * 128;
    const int hk = h / 3;
    const bf16* K = lat ? (const bf16*)(p.ws + WS_KGL) + (size_t)b * 1280 * 256 + hk * 128
                        : (const bf16*)(p.ws + WS_KGC) + (size_t)b * 256 * 256 + hk * 128;
    const bf16* V = lat ? (const bf16*)(p.ws + WS_VGL) + (size_t)(b * 2 + hk) * 128 * 1280
                        : (const bf16*)(p.ws + WS_VGC) + (size_t)(b * 2 + hk) * 128 * 256;
    f32x4 oa[8], ob[8];
    attn_pair(Q, 768, K, 256, V, S, 0.08838834764831845f * LOG2E, oa, ob, tid);
#pragma unroll
    for (int t = 0; t < 8; ++t) {
      uint2 w; w.x = pack2(oa[t][0], oa[t][1]); w.y = pack2(oa[t][2], oa[t][3]);
      *(uint2*)(MIX + (row + fr) * D + 512 + h * 128 + t * 16 + fq * 4) = w;
      uint2 w2; w2.x = pack2(ob[t][0], ob[t][1]); w2.y = pack2(ob[t][2], ob[t][3]);
      *(uint2*)(MIX + (row + 16 + fr) * D + 512 + h * 128 + t * 16 + fq * 4) = w2;
    }
  } else {
    const bf16* Q = (const bf16*)(p.ws + WS_QD) + row * 768 + h * 128;
    const bf16* K = lat ? (const bf16*)(p.ws + WS_KDL) + (size_t)b * 1280 * 768 + h * 128
                        : (const bf16*)(p.ws + WS_KDC) + (size_t)b * 256 * 768 + h * 128;
    const bf16* V = lat ? (const bf16*)(p.ws + WS_VDL) + (size_t)(b * 6 + h) * 128 * 1280
                        : (const bf16*)(p.ws + WS_VDC) + (size_t)(b * 6 + h) * 128 * 256;
    const float* lv = p.dlam + (size_t)l * 256;
    float d1 = wave_sum(lv[lane] * lv[64 + lane]);
    float d2 = wave_sum(lv[128 + lane] * lv[192 + lane]);
    float lam_init = 0.8f - 0.6f * expf(-0.3f * (float)l);
    float lam = expf(d1) - expf(d2) + lam_init;
    f32x4 o0[8], o1[8];
    attn_dual(Q, 768, K, 768, V, S, 0.125f * LOG2E, o0, o1, tid);
    float ss = 0.f;
#pragma unroll
    for (int t = 0; t < 8; ++t)
#pragma unroll
      for (int j = 0; j < 4; ++j) { o0[t][j] -= lam * o1[t][j]; ss += o0[t][j] * o0[t][j]; }
    ss += __shfl_xor(ss, 16);
    ss += __shfl_xor(ss, 32);
    float r = rsqrtf(ss * (1.f / 128.f) + EPS) * (1.f - lam_init);
    const float* sg = p.dsub + l * 128;
#pragma unroll
    for (int t = 0; t < 8; ++t) {
      float4 g4 = *(const float4*)(sg + t * 16 + fq * 4);
      uint2 w; w.x = pack2(o0[t][0] * r * g4.x, o0[t][1] * r * g4.y); w.y = pack2(o0[t][2] * r * g4.z, o0[t][3] * r * g4.w);
      *(uint2*)(MIX + (row + fr) * D + 1280 + h * 128 + t * 16 + fq * 4) = w;
    }
  }
}

constexpr int H_QD = 0;
constexpr int H_KD = H_QD + 64 * 136 * 2;
constexpr int H_KU = H_KD + 64 * 136 * 2;
constexpr int H_VT = H_KU + 128 * 72 * 2;
constexpr int H_ST = H_VT + 128 * 72 * 2;
constexpr int H_P = H_ST + 128 * 136 * 2;
constexpr int H_SEG = H_P + 64 * 72 * 2;
constexpr int H_BM = H_SEG + 4 * 128 * 4;
constexpr int H_END = H_BM + 4 * 128 * 4;
static_assert(H_END <= LDS_BYTES, "hgrn lds");

#define HGRN_FRONT(LOADQV) \
  float bb[16], kk[16]; \
  { const float* zp = PROJ + (size_t)(row0 + seg * 16) * INW + 1536 + dir * 512 + h * 128 + k; \
    const float* qp = PROJ + (size_t)(row0 + seg * 16) * INW + h * 128 + k; \
    const float* vp = qp + 512; \
    _Pragma("unroll") for (int i = 0; i < 16; ++i) { bb[i] = zp[(size_t)i * INW]; if (LOADQV) { qr[i] = qp[(size_t)i * INW]; vr[i] = vp[(size_t)i * INW]; } } \
    _Pragma("unroll") for (int i = 0; i < 16; ++i) { \
      float z = fminf(fmaxf(bb[i], -30.f), 30.f); \
      float ez = __expf(-z); \
      float sg = 1.f / (1.f + ez); \
      bb[i] = __logf(lbv + (1.f - lbv) * sg); \
      kk[i] = (1.f - lbv) * ez * sg; } } \
  if (!dir) { _Pragma("unroll") for (int i = 1; i < 16; ++i) bb[i] += bb[i - 1]; } \
  else { _Pragma("unroll") for (int i = 14; i >= 0; --i) bb[i] += bb[i + 1]; } \
  segtot[seg * 128 + k] = dir ? bb[0] : bb[15]; \
  __syncthreads(); \
  { float off = 0.f; \
    _Pragma("unroll") for (int s2 = 0; s2 < 4; ++s2) { float tv = segtot[s2 * 128 + k]; if (dir ? (s2 > seg) : (s2 < seg)) off += tv; } \
    _Pragma("unroll") for (int i = 0; i < 16; ++i) bb[i] += off; } \
  if (seg == 2) bmid_s[k] = bb[0]; \
  if (!dir && seg == 3) blast_s[k] = bb[15]; \
  if (dir && seg == 0) blast_s[k] = bb[0]; \
  __syncthreads();

#define HGRN_DECODE() \
  const bool lat = id < 256; \
  const int id2 = lat ? id : id - 256; \
  const int cc = lat ? 15 - (id2 >> 4) : 3 - (id2 >> 7); \
  const int scan = lat ? (id2 & 15) : (id2 & 127); \
  const int b = scan >> 3, h = (scan >> 1) & 3, dir = scan & 1; \
  const int nch = lat ? 16 : 4, rowbase = lat ? MC + b * 1024 : b * 256; \
  const int c = dir ? nch - 1 - cc : cc; \
  const int row0 = rowbase + c * 64; \
  const int slot0 = lat ? scan * 16 : 256 + scan * 4; \
  const int k = tid & 127, seg = tid >> 7; \
  const float lbv = ((const float*)(p.ws + WS_LB))[(l * 2 + dir) * 512 + h * 128 + k];

DEVI void hgrn_p1(int l, int id) {
  extern __shared__ __attribute__((aligned(16))) unsigned char g_lds[];
  P p; LOADP(ws);
  const int tid = otid(), lane = tid & 63, wave = tid >> 6, fr = lane & 15, fq = lane >> 4;
  unsigned short* KUs = (unsigned short*)(g_lds + H_KU);
  unsigned short* VTs = (unsigned short*)(g_lds + H_VT);
  float* segtot = (float*)(g_lds + H_SEG);
  float* bmid_s = (float*)(g_lds + H_BM);
  float* blast_s = bmid_s + 128;
  const float* PROJ = (const float*)(p.ws + WS_PROJ);
  HGRN_DECODE();
  float qr[16], vr[16];
  HGRN_FRONT(true);
  {
    const float bl = blast_s[k];
    unsigned ku[8], vv[8];
#pragma unroll
    for (int i = 0; i < 16; i += 2) {
      ku[i >> 1] = pack2(kk[i] * __expf(bl - bb[i]), kk[i + 1] * __expf(bl - bb[i + 1]));
      vv[i >> 1] = pack2(vr[i], vr[i + 1]);
    }
    uint4* kd = (uint4*)(KUs + k * 72 + seg * 16);
    kd[0] = uint4{ku[0], ku[1], ku[2], ku[3]}; kd[1] = uint4{ku[4], ku[5], ku[6], ku[7]};
    uint4* vd = (uint4*)(VTs + k * 72 + seg * 16);
    vd[0] = uint4{vv[0], vv[1], vv[2], vv[3]}; vd[1] = uint4{vv[4], vv[5], vv[6], vv[7]};
    if (seg == 0) ((float*)(p.ws + WS_HD))[(size_t)(slot0 + cc) * 128 + k] = __expf(bl);
  }
  __syncthreads();
  {
    f32x4 U[8];
#pragma unroll
    for (int vt = 0; vt < 8; ++vt) U[vt] = f32x4{0.f, 0.f, 0.f, 0.f};
#pragma unroll
    for (int ks = 0; ks < 2; ++ks) {
      bf16x8 af = *(const bf16x8*)(KUs + (wave * 16 + fr) * 72 + ks * 32 + fq * 8);
#pragma unroll
      for (int vt = 0; vt < 8; ++vt) {
        bf16x8 bf = *(const bf16x8*)(VTs + (vt * 16 + fr) * 72 + ks * 32 + fq * 8);
        U[vt] = __builtin_amdgcn_mfma_f32_16x16x32_bf16(af, bf, U[vt], 0, 0, 0);
      }
    }
    f32x4* hu = (f32x4*)(p.ws + WS_HU) + (size_t)(slot0 + cc) * 4096 + wave * 512 + lane;
#pragma unroll
    for (int vt = 0; vt < 8; ++vt) hu[vt * 64] = U[vt];
  }
  __syncthreads();
}

DEVI void hgrn_p3(int l, int id) {
  extern __shared__ __attribute__((aligned(16))) unsigned char g_lds[];
  P p; LOADP(ws); LOADP(out); LOADP(shg); LOADP(onorm_g);
  const int tid = otid(), lane = tid & 63, wave = tid >> 6, fr = lane & 15, fq = lane >> 4;
  unsigned short* QDs = (unsigned short*)(g_lds + H_QD);
  unsigned short* KDs = (unsigned short*)(g_lds + H_KD);
  unsigned short* QEs = (unsigned short*)(g_lds + H_KU);
  unsigned short* VTs = (unsigned short*)(g_lds + H_VT);
  unsigned short* STs = (unsigned short*)(g_lds + H_ST);
  unsigned short* Ps = (unsigned short*)(g_lds + H_P);
  float* segtot = (float*)(g_lds + H_SEG);
  float* bmid_s = (float*)(g_lds + H_BM);
  float* blast_s = bmid_s + 128;
  const float* PROJ = (const float*)(p.ws + WS_PROJ);
  const bool lat = id < 128;
  const int id2 = lat ? id : id - 128;
  const int nch = lat ? 16 : 4;
  const int c = lat ? (id2 & 15) : (id2 & 3);
  const int bh = lat ? (id2 >> 4) : (id2 >> 2);
  const int b = bh >> 2, h = bh & 3;
  const int row0 = (lat ? MC + b * 1024 : b * 256) + c * 64;
  const int k = tid & 127, seg = tid >> 7;
  const int tt = wave >> 1, vt0 = (wave & 1) * 4;
  f32x4 o[4];
#pragma unroll
  for (int n = 0; n < 4; ++n) o[n] = f32x4{0.f, 0.f, 0.f, 0.f};
  float qr[16], vr[16];
#pragma unroll
  for (int dir = 0; dir < 2; ++dir) {
    const int cc = dir ? nch - 1 - c : c;
    const int scan = bh * 2 + dir;
    const int slot0 = lat ? scan * 16 : 256 + scan * 4;
    const float lbv = ((const float*)(p.ws + WS_LB))[(l * 2 + dir) * 512 + h * 128 + k];
    f32x4 S[8];
    if (lat) {
      const float* st = p.shg + ((((size_t)b * 2 + l) * 2 + dir) * 4 + h) * 16384;
#pragma unroll
      for (int vt = 0; vt < 8; ++vt)
#pragma unroll
        for (int j = 0; j < 4; ++j) S[vt][j] = st[(wave * 16 + fq * 4 + j) * 128 + vt * 16 + fr];
    } else {
#pragma unroll
      for (int vt = 0; vt < 8; ++vt) S[vt] = f32x4{0.f, 0.f, 0.f, 0.f};
    }
#pragma unroll 2
    for (int j2 = 0; j2 < cc; ++j2) {
      const f32x4* hu = (const f32x4*)(p.ws + WS_HU) + (size_t)(slot0 + j2) * 4096 + wave * 512 + lane;
      const f32x4 dd = *(const f32x4*)((const float*)(p.ws + WS_HD) + (size_t)(slot0 + j2) * 128 + wave * 16 + fq * 4);
#pragma unroll
      for (int vt = 0; vt < 8; ++vt) { f32x4 u = hu[vt * 64]; S[vt] = S[vt] * dd + u; }
    }
#pragma unroll
    for (int vt = 0; vt < 8; ++vt) {
      uint2 w; w.x = pack2(S[vt][0], S[vt][1]); w.y = pack2(S[vt][2], S[vt][3]);
      *(uint2*)(STs + (vt * 16 + fr) * 136 + wave * 16 + fq * 4) = w;
    }
    if (!lat && cc == nch - 1) {
      const f32x4* hu = (const f32x4*)(p.ws + WS_HU) + (size_t)(slot0 + cc) * 4096 + wave * 512 + lane;
      const f32x4 dd = *(const f32x4*)((const float*)(p.ws + WS_HD) + (size_t)(slot0 + cc) * 128 + wave * 16 + fq * 4);
      float* so = p.out + O_HS + ((((size_t)b * 2 + l) * 2 + dir) * 4 + h) * 16384;
#pragma unroll
      for (int vt = 0; vt < 8; ++vt) {
        f32x4 u = hu[vt * 64];
        f32x4 sf = S[vt] * dd + u;
#pragma unroll
        for (int j = 0; j < 4; ++j) so[(wave * 16 + fq * 4 + j) * 128 + vt * 16 + fr] = sf[j];
      }
    }
    HGRN_FRONT(dir == 0);
    {
      const float bm = bmid_s[k];
      unsigned vv[8];
#pragma unroll
      for (int i = 0; i < 16; i += 2) {
        int t = seg * 16 + i;
        const float q0 = silu(qr[i]), q1 = silu(qr[i + 1]);
        QDs[t * 136 + k] = f2bf(q0 * __expf(bb[i] - bm));
        QDs[(t + 1) * 136 + k] = f2bf(q1 * __expf(bb[i + 1] - bm));
        QEs[t * 136 + k] = f2bf(q0 * __expf(bb[i]));
        QEs[(t + 1) * 136 + k] = f2bf(q1 * __expf(bb[i + 1]));
        KDs[t * 136 + k] = f2bf(kk[i] * __expf(bm - bb[i]));
        KDs[(t + 1) * 136 + k] = f2bf(kk[i + 1] * __expf(bm - bb[i + 1]));
        vv[i >> 1] = pack2(vr[i], vr[i + 1]);
      }
      if (dir == 0) {
        uint4* vd = (uint4*)(VTs + k * 72 + seg * 16);
        vd[0] = uint4{vv[0], vv[1], vv[2], vv[3]}; vd[1] = uint4{vv[4], vv[5], vv[6], vv[7]};
      }
    }
    __syncthreads();
    {
      const int st0 = (wave & 1) * 2;
      f32x4 a0 = f32x4{0.f, 0.f, 0.f, 0.f}, a1 = a0;
#pragma unroll
      for (int ks = 0; ks < 4; ++ks) {
        bf16x8 af = *(const bf16x8*)(QDs + (tt * 16 + fr) * 136 + ks * 32 + fq * 8);
        bf16x8 b0 = *(const bf16x8*)(KDs + (st0 * 16 + fr) * 136 + ks * 32 + fq * 8);
        bf16x8 b1 = *(const bf16x8*)(KDs + ((st0 + 1) * 16 + fr) * 136 + ks * 32 + fq * 8);
        a0 = __builtin_amdgcn_mfma_f32_16x16x32_bf16(af, b0, a0, 0, 0, 0);
        a1 = __builtin_amdgcn_mfma_f32_16x16x32_bf16(af, b1, a1, 0, 0, 0);
      }
#pragma unroll
      for (int j = 0; j < 4; ++j) {
        int t = tt * 16 + fq * 4 + j, s2 = st0 * 16 + fr;
        bool k0 = dir ? (s2 >= t) : (s2 <= t), k1 = dir ? (s2 + 16 >= t) : (s2 + 16 <= t);
        Ps[t * 72 + s2] = f2bf(k0 ? a0[j] : 0.f);
        Ps[t * 72 + s2 + 16] = f2bf(k1 ? a1[j] : 0.f);
      }
    }
    __syncthreads();
#pragma unroll
    for (int ks = 0; ks < 4; ++ks) {
      bf16x8 af = *(const bf16x8*)(QEs + (tt * 16 + fr) * 136 + ks * 32 + fq * 8);
#pragma unroll
      for (int n = 0; n < 4; ++n) {
        bf16x8 bf = *(const bf16x8*)(STs + ((vt0 + n) * 16 + fr) * 136 + ks * 32 + fq * 8);
        o[n] = __builtin_amdgcn_mfma_f32_16x16x32_bf16(af, bf, o[n], 0, 0, 0);
      }
    }
#pragma unroll
    for (int ks = 0; ks < 2; ++ks) {
      bf16x8 af = *(const bf16x8*)(Ps + (tt * 16 + fr) * 72 + ks * 32 + fq * 8);
#pragma unroll
      for (int n = 0; n < 4; ++n) {
        bf16x8 bf = *(const bf16x8*)(VTs + ((vt0 + n) * 16 + fr) * 72 + ks * 32 + fq * 8);
        o[n] = __builtin_amdgcn_mfma_f32_16x16x32_bf16(af, bf, o[n], 0, 0, 0);
      }
    }
    __syncthreads();
  }
  {
    float hgv[4][4];
    const float* hg = PROJ + (size_t)(row0 + tt * 16 + fq * 4) * INW + 1024 + h * 128 + vt0 * 16 + fr;
#pragma unroll
    for (int j = 0; j < 4; ++j)
#pragma unroll
      for (int n = 0; n < 4; ++n) hgv[j][n] = hg[(size_t)j * INW + n * 16];
    float ss[4];
#pragma unroll
    for (int j = 0; j < 4; ++j) {
      float a = 0.f;
#pragma unroll
      for (int n = 0; n < 4; ++n) a += o[n][j] * o[n][j];
      a += __shfl_xor(a, 1); a += __shfl_xor(a, 2); a += __shfl_xor(a, 4); a += __shfl_xor(a, 8);
      ss[j] = a;
    }
    float* red = segtot;
    if (fr == 0) {
#pragma unroll
      for (int j = 0; j < 4; ++j) red[(tt * 16 + fq * 4 + j) * 2 + (wave & 1)] = ss[j];
    }
    __syncthreads();
    unsigned short* MIX = (unsigned short*)(p.ws + WS_MIX);
    const float* g = p.onorm_g + l * 128 + vt0 * 16 + fr;
#pragma unroll
    for (int j = 0; j < 4; ++j) {
      const int t = tt * 16 + fq * 4 + j;
      const float r = rsqrtf((red[t * 2] + red[t * 2 + 1]) * (1.f / 128.f) + EPS);
#pragma unroll
      for (int n = 0; n < 4; ++n)
        MIX[(size_t)(row0 + t) * D + h * 128 + (vt0 + n) * 16 + fr] = f2bf(o[n][j] * r * g[n * 16] * silu(hgv[j][n]));
    }
  }
  __syncthreads();
}

DEVI void mix_phase(int l, int which) {
  __shared__ int s_item;
  int* ctr;
  { P p; LOADP(ws); ctr = (int*)(p.ws + WS_CTL) + l * 2 + which; }
  const int nitems = which == 0 ? 1184 : 816;
  while (true) {
    if (otid() == 0) s_item = atomicAdd(ctr, 1);
    __syncthreads();
    const int item = s_item;
    __syncthreads();
    if (item >= nitems) break;
    if (which == 0) {
      if (item < 416) prep_item(l, item);
      else hgrn_p1(l, item - 416);
    } else {
      if (item < 144) attn_item(l, item);
      else if (item < 528) hgrn_p3(l, item - 144);
      else attn_item(l, 144 + item - 528);
    }
  }
}

DEVI void comb_phase(int l) {
  P p; LOADP(ws); LOADP(onorm_g);
  const int tid = otid(), lane = tid & 63, wave = tid >> 6;
  const float* PROJ = (const float*)(p.ws + WS_PROJ);
  const float* OH = (const float*)(p.ws + WS_OH);
  unsigned short* MIX = (unsigned short*)(p.ws + WS_MIX);
  const float* g = p.onorm_g + l * 128;
  for (int u = obid() * 8 + wave; u < M * 4; u += ogdim() * 8) {
    int row = u >> 2, h = u & 3;
    const float* a = OH + (size_t)row * 512 + h * 128;
    const float* b2 = a + (size_t)M * 512;
    float x0 = a[lane] + b2[lane], x1 = a[64 + lane] + b2[64 + lane];
    float ss = wave_sum(x0 * x0 + x1 * x1);
    float r = rsqrtf(ss * (1.f / 128.f) + EPS);
    const float* hg = PROJ + (size_t)row * INW + 1024 + h * 128;
    MIX[(size_t)row * D + h * 128 + lane] = f2bf(x0 * r * g[lane] * silu(hg[lane]));
    MIX[(size_t)row * D + h * 128 + 64 + lane] = f2bf(x1 * r * g[64 + lane] * silu(hg[64 + lane]));
  }
}

constexpr int NPHASE = 23;
#define RUN(idx, ...) do { if (ph_lo <= (idx) && (idx) < ph_hi) { if ((idx) > ph_lo && (idx) > 1) xcd_barrier(); __VA_ARGS__; } } while (0)
constexpr int GMF = 4;
template <int L>
DEVI void layer_program(cg::grid_group& grid, const int ph_lo, const int ph_hi) {
  constexpr int B0 = 1 + L * 11;
  RUN(B0 + 0, norm_phase(L, 0, L == 0));
  RUN(B0 + 1, { P p; LOADP(ws);
    gemm_phase<1, GMF, false, 1>((const bf16*)(p.ws + WS_H), (const bf16*)(p.ws + WS_WT) + (size_t)L * WL_ELEMS + WL_GU, M, 2 * FF, D, nullptr, (bf16*)(p.ws + WS_ACT), nullptr, 0.f);
    side_work(1 + L * 6 + 0, L * SIDE_PER_LAYER + SR_G2); });
  RUN(B0 + 2, { P p; LOADP(ws); LOADP(out); LOADP(x_prompt); LOADP(x_sample);
    unsigned* lflags = (unsigned*)(p.ws + WS_CTL) + 64 + (L * 2 + 0) * 8;
    gemm_phase<1, GMF, false, 3>((const bf16*)(p.ws + WS_H), (const bf16*)(p.ws + WS_WT) + (size_t)L * WL_ELEMS + WL_GU, M, 2 * FF, D, nullptr, (bf16*)(p.ws + WS_ACT), nullptr, 0.f,
                  nullptr, nullptr, lflags);
    gemm_phase<2, GMF, L == 0, 2>((const bf16*)(p.ws + WS_ACT), (const bf16*)(p.ws + WS_WT) + (size_t)L * WL_ELEMS + WL_D, M, D, FF, p.out, nullptr,
                  (const float*)(p.ws + WS_MOD) + (size_t)L * 3 * NMODW + 2 * D, 0.5f, p.x_prompt, p.x_sample, lflags);
    side_work(1 + L * 6 + 1, L * SIDE_PER_LAYER + SR_G4); });
  RUN(B0 + 3, norm_phase(L, 1));
  RUN(B0 + 4, { P p; LOADP(ws);
    gemm_phase<0, GMF>((const bf16*)(p.ws + WS_H), (const bf16*)(p.ws + WS_WT) + (size_t)L * WL_ELEMS + WL_IN, M, INW, D, (float*)(p.ws + WS_PROJ), nullptr, nullptr, 0.f);
    side_work(1 + L * 6 + 2, L * SIDE_PER_LAYER + SR_G5); });
  RUN(B0 + 5, mix_phase(L, 0));
  RUN(B0 + 6, mix_phase(L, 1));
  RUN(B0 + 7, { P p; LOADP(ws); LOADP(out);
    gemm_phase<2, GMF>((const bf16*)(p.ws + WS_MIX), (const bf16*)(p.ws + WS_WT) + (size_t)L * WL_ELEMS + WL_OUT, M, D, D, p.out, nullptr,
                  (const float*)(p.ws + WS_MOD) + (size_t)L * 3 * NMODW + 5 * D, 1.f);
    side_work(1 + L * 6 + 3, L * SIDE_PER_LAYER + SR_G6); });
  RUN(B0 + 8, norm_phase(L, 2));
  RUN(B0 + 9, { P p; LOADP(ws);
    gemm_phase<1, GMF, false, 1>((const bf16*)(p.ws + WS_H), (const bf16*)(p.ws + WS_WT) + (size_t)L * WL_ELEMS + WL_GU + (size_t)11264 * 2048, M, 2 * FF, D, nullptr, (bf16*)(p.ws + WS_ACT), nullptr, 0.f);
    side_work(1 + L * 6 + 4, L * SIDE_PER_LAYER + SR_G6); });
  RUN(B0 + 10, { P p; LOADP(ws); LOADP(out);
    unsigned* lflags = (unsigned*)(p.ws + WS_CTL) + 64 + (L * 2 + 1) * 8;
    gemm_phase<1, GMF, false, 3>((const bf16*)(p.ws + WS_H), (const bf16*)(p.ws + WS_WT) + (size_t)L * WL_ELEMS + WL_GU + (size_t)11264 * 2048, M, 2 * FF, D, nullptr, (bf16*)(p.ws + WS_ACT), nullptr, 0.f,
                  nullptr, nullptr, lflags);
    gemm_phase<2, GMF, false, 2>((const bf16*)(p.ws + WS_ACT), (const bf16*)(p.ws + WS_WT) + (size_t)L * WL_ELEMS + WL_D + (size_t)2048 * 5632, M, D, FF, p.out, nullptr,
                  (const float*)(p.ws + WS_MOD) + (size_t)L * 3 * NMODW + 8 * D, 0.5f, nullptr, nullptr, lflags);
    side_work(1 + L * 6 + 5, (L == 0 ? SIDE_PER_LAYER + SR_G2 : SIDE_TOTAL)); });
}

__global__ void __launch_bounds__(NT) fwd_kernel(P parg) {
  extern __shared__ __attribute__((aligned(16))) unsigned char g_lds[];
  cg::grid_group grid = cg::this_grid();
  const int ph_lo = karg_int((int)__builtin_offsetof(P, ph_lo)), ph_hi = karg_int((int)__builtin_offsetof(P, ph_hi));
  if (otid() < 4) ((volatile LAS unsigned*)(g_lds + XB_ST_OFF))[otid()] = 0u;
  __syncthreads();
  RUN(0, phase0());
  if (ph_lo == 0 && ph_hi > 1) {
    grid.sync();
    xcd_barrier_post();
  }
  layer_program<0>(grid, ph_lo, ph_hi);
  layer_program<1>(grid, ph_lo, ph_hi);
}

extern "C" void kernel_launch(void* const* d_in, const int* in_sizes, int n_in, void* d_out, int out_size,
                              void* d_ws, size_t ws_size, hipStream_t stream) {
  static int grid_blocks = 0;
  if (!grid_blocks) {
    if (ws_size < WS_END) { fprintf(stderr, "kernel_launch: workspace too small: %zu < %zu\n", ws_size, (size_t)WS_END); grid_blocks = -1; return; }
    int dev = 0, cus = 0, per_cu = 0;
    hipGetDevice(&dev);
    hipDeviceGetAttribute(&cus, hipDeviceAttributeMultiprocessorCount, dev);
    if (hipFuncSetAttribute((const void*)fwd_kernel, hipFuncAttributeMaxDynamicSharedMemorySize, LDS_BYTES) != hipSuccess)
      fprintf(stderr, "kernel_launch: hipFuncSetAttribute failed\n");
    hipOccupancyMaxActiveBlocksPerMultiprocessor(&per_cu, (const void*)fwd_kernel, NT, LDS_BYTES);
    if (per_cu < 1) { fprintf(stderr, "kernel_launch: occupancy query says %d blocks/CU\n", per_cu); per_cu = 1; }
    (void)hipGetLastError();
    grid_blocks = cus * per_cu;
  }
  if (grid_blocks < 0) return;
  (void)hipMemsetAsync(d_ws, 0, WS_MOD, stream);
  P p{};
  const float** pp = (const float**)&p;
  for (int i = 0; i < 25; ++i) pp[i] = (const float*)d_in[i];
  p.out = (float*)d_out; p.ws = (unsigned char*)d_ws;
#if ONE_LAUNCH
  p.ph_lo = 0; p.ph_hi = NPHASE;
  void* args[] = {&p};
  hipError_t e = hipLaunchCooperativeKernel((const void*)fwd_kernel, dim3(grid_blocks), dim3(NT), args, LDS_BYTES, stream);
  if (e != hipSuccess) fprintf(stderr, "cooperative launch failed: %s (grid %d)\n", hipGetErrorString(e), grid_blocks);
#else
  for (int ph = 0; ph < NPHASE; ++ph) {
    p.ph_lo = ph; p.ph_hi = ph + 1;
    hipLaunchKernelGGL(fwd_kernel, dim3(grid_blocks), dim3(NT), LDS_BYTES, stream, p);
  }
#endif
}
```
